# Optimizing an MI355X kernel written in HIP

```python
import math
import jax
import jax.numpy as jnp
from jax import lax
import numpy as np

D_MODEL = 2048
BATCH = 8
SEQ = 4096
DEPTH = 2

CTX_LEN = 256
GRID_W = 64
Q_BLOCK = 128
ROPE_THETA = 10000.0
NORM_EPS = 1e-6
N_MOD = 9
D_FF = 5632
BRANCH_W = 1024
N_BRANCH = 3

MLA_HEADS = 8
MLA_Q_LORA = 1536
MLA_KV_LORA = 512
MLA_NOPE = 128
MLA_ROPE = 64
MLA_V = 128
MLA_SCALE = (MLA_NOPE + MLA_ROPE) ** -0.5

S5_W = 1024
S5_H = 16
S5_G = S5_W // S5_H
S5_P = 64
S5_DT_MIN = 1e-3
S5_DT_MAX = 1e-1
S5_LAMBDA_RE_MAX = -1e-4

GQA_Q_HEADS = 8
GQA_KV_HEADS = 2
GQA_HEAD_DIM = 128
GQA_SCALE = GQA_HEAD_DIM ** -0.5

IN_WIDTHS = (MLA_Q_LORA, MLA_KV_LORA, MLA_ROPE, S5_W,
             GQA_Q_HEADS * GQA_HEAD_DIM, GQA_KV_HEADS * GQA_HEAD_DIM, GQA_KV_HEADS * GQA_HEAD_DIM)
D_IN = sum(IN_WIDTHS)
IN_OFFSETS = tuple(int(v) for v in np.cumsum(IN_WIDTHS)[:-1])

kernel_name = 'hybrid_mla_s5_gqa_macaron_dit'


def rms_norm(x, g):
    xf = x.astype(jnp.float32)
    y = xf * lax.rsqrt(jnp.mean(xf * xf, axis=-1, keepdims=True) + NORM_EPS)
    return (y * g.astype(jnp.float32)).astype(x.dtype)


def modulate(h, shift, scale):
    return h * (1 + scale) + shift


def swiglu(h, w_up, w_down):
    gate, up = jnp.split(h @ w_up, 2, axis=-1)
    return (jax.nn.silu(gate) * up) @ w_down


def grid_positions(n_tokens):
    rows = n_tokens // GRID_W
    r, col = jnp.meshgrid(jnp.arange(rows, dtype=jnp.int32), jnp.arange(GRID_W, dtype=jnp.int32), indexing='ij')
    return r.reshape(-1), col.reshape(-1)


def axial_rope_tables(rows, cols, d_rot):
    half = d_rot // 2
    freqs = ROPE_THETA ** (-jnp.arange(0, half, 2, dtype=jnp.float32) / half)

    def table(pos):
        ang = pos.astype(jnp.float32)[:, None] * freqs[None, :]
        ang = jnp.concatenate([ang, ang], axis=-1)
        return jnp.cos(ang), jnp.sin(ang)

    cr, sr = table(rows)
    cc, sc = table(cols)
    return jnp.concatenate([cr, cc], axis=-1), jnp.concatenate([sr, sc], axis=-1)


def rotate_half(v):
    v1, v2 = jnp.split(v, 2, axis=-1)
    return jnp.concatenate([-v2, v1], axis=-1)


def apply_axial_rope(x, rope):
    cos, sin = rope
    half = x.shape[-1] // 2
    xf = x.astype(jnp.float32)
    rotated = jnp.concatenate([rotate_half(xf[..., :half]), rotate_half(xf[..., half:])], axis=-1)
    return (xf * cos[:, None, :] + rotated * sin[:, None, :]).astype(x.dtype)


def blocked_attention(q, k, v, scale):
    b, lq, hq, dk = q.shape
    hkv, dv = k.shape[2], v.shape[-1]
    grp = hq // hkv
    nb = lq // Q_BLOCK
    qb = jnp.moveaxis(q.reshape(b, nb, Q_BLOCK, hkv, grp, dk), 1, 0)

    def one_block(q_blk):
        s = jnp.einsum('bqkgd,bskd->bkgqs', q_blk, k).astype(jnp.float32) * scale
        pr = jax.nn.softmax(s, axis=-1).astype(v.dtype)
        return jnp.einsum('bkgqs,bskd->bqkgd', pr, v)

    o = lax.map(one_block, qb)
    return jnp.moveaxis(o, 0, 1).reshape(b, lq, hq * dv)


def mla_q(cq, p, rope):
    b, l = cq.shape[:2]
    q = (rms_norm(cq, p['g_cq']) @ p['w_uq']).reshape(b, l, MLA_HEADS, MLA_NOPE + MLA_ROPE)
    q_nope, q_rope = q[..., :MLA_NOPE], q[..., MLA_NOPE:]
    if rope is not None:
        q_rope = apply_axial_rope(q_rope, rope)
    return jnp.concatenate([q_nope, q_rope], axis=-1)


def mla_kv(ckv, kr, p, rope):
    b, l = ckv.shape[:2]
    kv = (rms_norm(ckv, p['g_ckv']) @ p['w_ukv']).reshape(b, l, MLA_HEADS, MLA_NOPE + MLA_V)
    k_nope, v = kv[..., :MLA_NOPE], kv[..., MLA_NOPE:]
    k_rope = kr[:, :, None, :]
    if rope is not None:
        k_rope = apply_axial_rope(k_rope, rope)
    k_rope = jnp.broadcast_to(k_rope, (b, l, MLA_HEADS, MLA_ROPE))
    return jnp.concatenate([k_nope, k_rope], axis=-1), v


def gqa_q(gq, p, rope):
    b, l = gq.shape[:2]
    q = rms_norm(gq.reshape(b, l, GQA_Q_HEADS, GQA_HEAD_DIM), p['g_q'])
    return apply_axial_rope(q, rope) if rope is not None else q


def gqa_kv(gk, gv, p, rope):
    b, l = gk.shape[:2]
    k = rms_norm(gk.reshape(b, l, GQA_KV_HEADS, GQA_HEAD_DIM), p['g_k'])
    if rope is not None:
        k = apply_axial_rope(k, rope)
    return k, gv.reshape(b, l, GQA_KV_HEADS, GQA_HEAD_DIM)


def s5_discretize(lam_re, lam_im, log_dt, b_re, b_im):
    lr = jnp.minimum(lam_re.astype(jnp.float32), S5_LAMBDA_RE_MAX)
    li = lam_im.astype(jnp.float32)
    dt = jnp.exp(log_dt.astype(jnp.float32))[:, None]
    mag = jnp.exp(lr * dt)
    a_r, a_i = mag * jnp.cos(li * dt), mag * jnp.sin(li * dt)
    den = lr * lr + li * li
    n_r, n_i = a_r - 1.0, a_i
    f_r = (n_r * lr + n_i * li) / den
    f_i = (n_i * lr - n_r * li) / den
    br, bi = b_re.astype(jnp.float32), b_im.astype(jnp.float32)
    bb_r = f_r[..., None] * br - f_i[..., None] * bi
    bb_i = f_r[..., None] * bi + f_i[..., None] * br
    return a_r, a_i, bb_r, bb_i


def complex_affine_combine(e1, e2):
    a1r, a1i, b1r, b1i = e1
    a2r, a2i, b2r, b2i = e2
    return (a2r * a1r - a2i * a1i,
            a2r * a1i + a2i * a1r,
            a2r * b1r - a2i * b1i + b2r,
            a2r * b1i + a2i * b1r + b2i)


def s5_scan(u, disc, h0, reverse):
    a_r, a_i, bb_r, bb_i = disc
    bu_r = jnp.einsum('blgh,gph->blgp', u, bb_r)
    bu_i = jnp.einsum('blgh,gph->blgp', u, bb_i)
    shape = (1,) + bu_r.shape[1:]
    cum_r, cum_i, s_r, s_i = lax.associative_scan(
        complex_affine_combine,
        (jnp.broadcast_to(a_r, shape), jnp.broadcast_to(a_i, shape), bu_r, bu_i),
        reverse=reverse, axis=1)
    if h0 is not None:
        h_r, h_i = h0[0][:, None], h0[1][:, None]
        s_r, s_i = s_r + cum_r * h_r - cum_i * h_i, s_i + cum_r * h_i + cum_i * h_r
    return s_r, s_i


def s5_readout(s_r, s_i, c_re, c_im):
    return jnp.einsum('blgp,ghp->blgh', s_r, c_re) - jnp.einsum('blgp,ghp->blgh', s_i, c_im)


def s5_glu(y, w, bias):
    return y * jax.nn.sigmoid(jax.nn.gelu(y) @ w.astype(jnp.float32) + bias.astype(jnp.float32))


def s5_mixer(u_lat, u_ctx, p, ctx_out):
    b, l = u_lat.shape[:2]
    lc = u_ctx.shape[1]
    ul = u_lat.astype(jnp.float32).reshape(b, l, S5_G, S5_H)
    uc = u_ctx.astype(jnp.float32).reshape(b, lc, S5_G, S5_H)
    d_skip = p['s5_d'].astype(jnp.float32)
    y_lat = ul * d_skip
    y_ctx = uc * d_skip if ctx_out else None
    for direction in range(2):
        reverse = direction == 1
        disc = s5_discretize(p['lam_re'][direction], p['lam_im'][direction], p['log_dt'][direction],
                             p['b_re'][direction], p['b_im'][direction])
        c_re = p['c_re'][direction].astype(jnp.float32)
        c_im = p['c_im'][direction].astype(jnp.float32)
        sc_r, sc_i = s5_scan(uc, disc, None, reverse)
        edge = 0 if reverse else -1
        sl_r, sl_i = s5_scan(ul, disc, (sc_r[:, edge], sc_i[:, edge]), reverse)
        y_lat = y_lat + s5_readout(sl_r, sl_i, c_re, c_im)
        if ctx_out:
            y_ctx = y_ctx + s5_readout(sc_r, sc_i, c_re, c_im)
    out_lat = s5_glu(y_lat.reshape(b, l, S5_W), p['w_glu'], p['b_glu']).astype(u_lat.dtype)
    if not ctx_out:
        return out_lat, None
    out_ctx = s5_glu(y_ctx.reshape(b, lc, S5_W), p['w_glu'], p['b_glu']).astype(u_ctx.dtype)
    return out_lat, out_ctx


def gated_merge(h, branches, p):
    y = None
    for n, br in enumerate(branches):
        gate = jax.nn.sigmoid(h @ p['w_gate'][n] + p['b_gate'][n])
        term = gate * (br @ p['w_branch'][n])
        y = term if y is None else y + term
    return y @ p['w_o']


def token_mixer(h_lat, h_ctx, p, rope_mla, rope_gqa, ctx_out):
    z_lat = h_lat @ p['w_in']
    z_ctx = h_ctx @ p['w_in']
    cq_l, ckv_l, kr_l, u_l, gq_l, gk_l, gv_l = jnp.split(z_lat, IN_OFFSETS, axis=-1)
    cq_c, ckv_c, kr_c, u_c, gq_c, gk_c, gv_c = jnp.split(z_ctx, IN_OFFSETS, axis=-1)

    mk_c, mv_c = mla_kv(ckv_c, kr_c, p, None)
    mk_l, mv_l = mla_kv(ckv_l, kr_l, p, rope_mla)
    mla_l = blocked_attention(mla_q(cq_l, p, rope_mla), jnp.concatenate([mk_c, mk_l], axis=1),
                              jnp.concatenate([mv_c, mv_l], axis=1), MLA_SCALE)

    s5_l, s5_c = s5_mixer(u_l, u_c, p, ctx_out)

    gk_cc, gv_cc = gqa_kv(gk_c, gv_c, p, None)
    gk_ll, gv_ll = gqa_kv(gk_l, gv_l, p, rope_gqa)
    gqa_l = blocked_attention(gqa_q(gq_l, p, rope_gqa), jnp.concatenate([gk_cc, gk_ll], axis=1),
                              jnp.concatenate([gv_cc, gv_ll], axis=1), GQA_SCALE)

    out_lat = gated_merge(h_lat, (mla_l, s5_l, gqa_l), p)
    if not ctx_out:
        return out_lat, None
    mla_c = blocked_attention(mla_q(cq_c, p, None), mk_c, mv_c, MLA_SCALE)
    gqa_c = blocked_attention(gqa_q(gq_c, p, None), gk_cc, gv_cc, GQA_SCALE)
    out_ctx = gated_merge(h_ctx, (mla_c, s5_c, gqa_c), p)
    return out_lat, out_ctx


def hybrid_layer(x_lat, x_ctx, ml, mc, p, rope_mla, rope_gqa, last):
    g = p['norm_g']
    up, down = p['ffn_up'], p['ffn_down']
    x_lat = x_lat + 0.5 * ml[2] * swiglu(modulate(rms_norm(x_lat, g[0]), ml[0], ml[1]), up[0], down[0])
    x_ctx = x_ctx + 0.5 * mc[2] * swiglu(modulate(rms_norm(x_ctx, g[0]), mc[0], mc[1]), up[0], down[0])
    h_lat = modulate(rms_norm(x_lat, g[1]), ml[3], ml[4])
    h_ctx = modulate(rms_norm(x_ctx, g[1]), mc[3], mc[4])
    out_lat, out_ctx = token_mixer(h_lat, h_ctx, p, rope_mla, rope_gqa, not last)
    x_lat = x_lat + ml[5] * out_lat
    x_lat = x_lat + 0.5 * ml[8] * swiglu(modulate(rms_norm(x_lat, g[2]), ml[6], ml[7]), up[1], down[1])
    if last:
        return x_lat, None
    x_ctx = x_ctx + mc[5] * out_ctx
    x_ctx = x_ctx + 0.5 * mc[8] * swiglu(modulate(rms_norm(x_ctx, g[2]), mc[6], mc[7]), up[1], down[1])
    return x_lat, x_ctx


def setup_inputs(seed: int = 0) -> dict:
    key = jax.random.key(seed)
    ks = iter(jax.random.split(key, 40))
    f32 = jnp.float32
    D = D_MODEL

    def normal(shape, scale):
        return jax.random.normal(next(ks), shape, f32) * scale

    def gain(shape):
        return 1.0 + normal(shape, 0.02)

    return {
        'x': normal((BATCH, SEQ, D), 1.0),
        'c': normal((BATCH, D), 1.0),
        'ctx': normal((BATCH, CTX_LEN, D), 1.0),
        'c_ctx': normal((D,), 1.0),
        'w_mod': normal((DEPTH, D, N_MOD * D), 0.5 * D ** -0.5),
        'b_mod': normal((DEPTH, N_MOD * D), 0.02),
        'norm_g': gain((DEPTH, 3, D)),
        'w_ffn_up': normal((DEPTH, 2, D, 2 * D_FF), D ** -0.5),
        'w_ffn_down': normal((DEPTH, 2, D_FF, D), D_FF ** -0.5),
        'w_in': normal((DEPTH, D, D_IN), D ** -0.5),
        'mla_g_cq': gain((DEPTH, MLA_Q_LORA)),
        'mla_g_ckv': gain((DEPTH, MLA_KV_LORA)),
        'mla_w_uq': normal((DEPTH, MLA_Q_LORA, MLA_HEADS * (MLA_NOPE + MLA_ROPE)), MLA_Q_LORA ** -0.5),
        'mla_w_ukv': normal((DEPTH, MLA_KV_LORA, MLA_HEADS * (MLA_NOPE + MLA_V)), MLA_KV_LORA ** -0.5),
        'gqa_g_q': gain((DEPTH, GQA_HEAD_DIM)),
        'gqa_g_k': gain((DEPTH, GQA_HEAD_DIM)),
        's5_lam_re': -0.5 + normal((DEPTH, 2, S5_G, S5_P), 0.01),
        's5_lam_im': math.pi * jnp.arange(S5_P, dtype=f32) + normal((DEPTH, 2, S5_G, S5_P), 0.01),
        's5_log_dt': jax.random.uniform(next(ks), (DEPTH, 2, S5_G), f32,
                                        minval=math.log(S5_DT_MIN), maxval=math.log(S5_DT_MAX)),
        's5_b_re': normal((DEPTH, 2, S5_G, S5_P, S5_H), (2 * S5_H) ** -0.5),
        's5_b_im': normal((DEPTH, 2, S5_G, S5_P, S5_H), (2 * S5_H) ** -0.5),
        's5_c_re': normal((DEPTH, 2, S5_G, S5_H, S5_P), S5_P ** -0.5),
        's5_c_im': normal((DEPTH, 2, S5_G, S5_H, S5_P), S5_P ** -0.5),
        's5_d': normal((DEPTH, S5_G, S5_H), 1.0),
        's5_w_glu': normal((DEPTH, S5_W, S5_W), S5_W ** -0.5),
        's5_b_glu': normal((DEPTH, S5_W), 0.02),
        'w_gate': normal((DEPTH, N_BRANCH, D, D), D ** -0.5),
        'b_gate': normal((DEPTH, N_BRANCH, D), 0.02),
        'w_branch': normal((DEPTH, N_BRANCH, BRANCH_W, D), BRANCH_W ** -0.5),
        'w_o': normal((DEPTH, D, D), D ** -0.5),
        'final_g': gain((D,)),
    }


def reference(x, c, ctx, c_ctx, w_mod, b_mod, norm_g, w_ffn_up, w_ffn_down, w_in,
              mla_g_cq, mla_g_ckv, mla_w_uq, mla_w_ukv, gqa_g_q, gqa_g_k,
              s5_lam_re, s5_lam_im, s5_log_dt, s5_b_re, s5_b_im, s5_c_re, s5_c_im, s5_d,
              s5_w_glu, s5_b_glu, w_gate, b_gate, w_branch, w_o, final_g):
    b, l, d = x.shape
    rows, cols = grid_positions(l)
    rope_mla = axial_rope_tables(rows, cols, MLA_ROPE)
    rope_gqa = axial_rope_tables(rows, cols, GQA_HEAD_DIM)
    x_lat, x_ctx = x, ctx
    for li in range(DEPTH):
        m_lat = (jax.nn.silu(c) @ w_mod[li] + b_mod[li]).reshape(b, N_MOD, d)
        m_ctx = (jax.nn.silu(c_ctx) @ w_mod[li] + b_mod[li]).reshape(N_MOD, d)
        ml = [m_lat[:, i, None, :] for i in range(N_MOD)]
        mc = [m_ctx[i][None, None, :] for i in range(N_MOD)]
        p = {
            'norm_g': norm_g[li], 'ffn_up': w_ffn_up[li], 'ffn_down': w_ffn_down[li], 'w_in': w_in[li],
            'g_cq': mla_g_cq[li], 'g_ckv': mla_g_ckv[li], 'w_uq': mla_w_uq[li], 'w_ukv': mla_w_ukv[li],
            'g_q': gqa_g_q[li], 'g_k': gqa_g_k[li],
            'lam_re': s5_lam_re[li], 'lam_im': s5_lam_im[li], 'log_dt': s5_log_dt[li],
            'b_re': s5_b_re[li], 'b_im': s5_b_im[li], 'c_re': s5_c_re[li], 'c_im': s5_c_im[li],
            's5_d': s5_d[li], 'w_glu': s5_w_glu[li], 'b_glu': s5_b_glu[li],
            'w_gate': w_gate[li], 'b_gate': b_gate[li], 'w_branch': w_branch[li], 'w_o': w_o[li],
        }
        x_lat, x_ctx = hybrid_layer(x_lat, x_ctx, ml, mc, p, rope_mla, rope_gqa, li == DEPTH - 1)
    return rms_norm(x_lat, final_g)
```

```cpp
#include <hip/hip_runtime.h>
#include <cstdio>
#include <cstdint>

#ifndef MK_PER_PHASE
#define MK_PER_PHASE 0
#endif

#ifndef PHMASK
#define PHMASK 0x7FFFFFu
#endif
#define PHON(k) (((PHMASK) >> (k)) & 1u)
#define GAS __attribute__((address_space(1)))
#define LAS __attribute__((address_space(3)))
typedef unsigned short bf16_t;
typedef short bf16x8 __attribute__((ext_vector_type(8)));
typedef short s16x4 __attribute__((ext_vector_type(4)));
typedef float f32x2 __attribute__((ext_vector_type(2)));
typedef float f32x4 __attribute__((ext_vector_type(4)));
typedef float f32x8 __attribute__((ext_vector_type(8)));
typedef float f32x16 __attribute__((ext_vector_type(16)));
typedef unsigned u32x2 __attribute__((ext_vector_type(2)));
typedef unsigned u32x4 __attribute__((ext_vector_type(4)));

constexpr int DM = 2048, NB = 8, SEQ = 4096, CTXL = 256, TOK = SEQ + CTXL, MR = NB * TOK, NTM = MR / 256, TPB = TOK / 256;
constexpr int DEPTH = 2, NMODV = 9, DFF = 5632, DINP = 4864;
constexpr int DFFP = 5696;
constexpr int NCH = TOK / 16, CHR = NB * NCH, CHRP = 2304;
constexpr float EPS = 1e-6f;

constexpr size_t MiB = (size_t)1 << 20;
constexpr size_t WS_CTL = 0, CTL_ZERO_BYTES = 65536;
constexpr size_t WS_MOD = 1 * MiB;
constexpr size_t WS_ROPEG = 3 * MiB, WS_ROPEM = 3 * MiB + 16384, WS_RS = 3 * MiB + 65536;
constexpr size_t WS_S5P = 4 * MiB, WS_S5BB = 6 * MiB, WS_S5K = 7 * MiB, WS_WE = 9 * MiB, WS_WC = 17 * MiB;
constexpr size_t WS_WB = 33 * MiB, WS_X = 237 * MiB, WS_H = 509 * MiB, WS_AR = 645 * MiB, WS_END = 1338 * MiB;
constexpr size_t WB_UP0 = 0, WB_UP1 = WB_UP0 + (size_t)11264 * 2048, WB_DN0 = WB_UP1 + (size_t)11264 * 2048, WB_DN1 = WB_DN0 + (size_t)2048 * DFFP,
                 WB_WIN = WB_DN1 + (size_t)2048 * DFFP, WB_WUQ = WB_WIN + (size_t)DINP * 2048, WB_WUKV = WB_WUQ + (size_t)1536 * 1536, WB_WGLU = WB_WUKV + (size_t)2048 * 512,
                 WB_WG = WB_WGLU + (size_t)1024 * 1024, WB_WBR = WB_WG + (size_t)3 * 2048 * 2048, WB_WO = WB_WBR + (size_t)3 * 2048 * 1024, WB_TOTAL = WB_WO + (size_t)2048 * 2048;
static_assert(WS_WB + WB_TOTAL * 2 <= WS_X, "weights fit");
constexpr size_t AR_HID = 0, AR_ZA = 0, AR_OMLA = 0, AR_OGQA = 68 * MiB, AR_Q = 136 * MiB, AR_KV = 238 * MiB, AR_E = 136 * MiB, AR_YS = 280 * MiB, AR_Y = 136 * MiB,
                 AR_UGS = 374 * MiB, AR_GQ = 518 * MiB, AR_BRS5 = 518 * MiB, AR_GKV = 586 * MiB, AR_GS = 586 * MiB, AR_KR = 620 * MiB, AR_GEL = 625 * MiB, AR_END = 693 * MiB;
static_assert(WS_AR + AR_END <= WS_END, "arena fits");

constexpr int LDS_BYTES = 147456, MISC_OFF = LDS_BYTES - 256;

constexpr int NPL = 21, PH_FINAL = 1 + DEPTH * NPL, NPH = PH_FINAL + 1;

#define LDS_WAIT() asm volatile("s_waitcnt lgkmcnt(0)" ::: "memory")
#define VM_WAIT() asm volatile("s_waitcnt vmcnt(0)" ::: "memory")

typedef __bf16 bf16x2_t __attribute__((ext_vector_type(2)));
__device__ __forceinline__ unsigned cvt_pk_bf16(float lo, float hi) { f32x2 v = {lo, hi}; bf16x2_t b = __builtin_convertvector(v, bf16x2_t); return __builtin_bit_cast(unsigned, b); }
typedef _Float16 f16_t;
typedef _Float16 f16x2_t __attribute__((ext_vector_type(2)));
__device__ __forceinline__ unsigned cvt_pk_f16(float lo, float hi) { f32x2 v = {lo, hi}; f16x2_t h = __builtin_convertvector(v, f16x2_t); return __builtin_bit_cast(unsigned, h); }
__device__ __forceinline__ f32x2 h2f2(unsigned w) { return __builtin_convertvector(__builtin_bit_cast(f16x2_t, w), f32x2); }
__device__ __forceinline__ void h8f(const u32x4 h, f32x4& a, f32x4& b) { const f32x2 p = h2f2(h.x), q = h2f2(h.y), r = h2f2(h.z), t = h2f2(h.w); a = (f32x4){p.x, p.y, q.x, q.y}; b = (f32x4){r.x, r.y, t.x, t.y}; }
__device__ __forceinline__ u32x4 f8h(const f32x4 a, const f32x4 b) { u32x4 w; w.x = cvt_pk_f16(a.x, a.y); w.y = cvt_pk_f16(a.z, a.w); w.z = cvt_pk_f16(b.x, b.y); w.w = cvt_pk_f16(b.z, b.w); return w; }
__device__ __forceinline__ float bf_lo(unsigned w) { return __uint_as_float(w << 16); }
__device__ __forceinline__ float bf_hi(unsigned w) { return __uint_as_float(w & 0xffff0000u); }
__device__ __forceinline__ float bf2f(bf16_t b) { return __uint_as_float(((unsigned)b) << 16); }
__device__ __forceinline__ bf16_t f2bf(float f) { return (bf16_t)(cvt_pk_bf16(f, 0.f) & 0xffffu); }
__device__ __forceinline__ float sigmoidf_(float x) { return __builtin_amdgcn_rcpf(1.0f + __builtin_amdgcn_exp2f(-1.4426950408889634f * x)); }
__device__ __forceinline__ float siluf_(float x) { return x * sigmoidf_(x); }
__device__ __forceinline__ float gelu_tanh_(float x) { const float z = 0.7978845608028654f * (x + 0.044715f * x * x * x); return x * sigmoidf_(2.0f * z); }
__device__ __forceinline__ float wave_sum(float v) {
#pragma unroll
    for (int o = 1; o < 64; o <<= 1) v += __shfl_xor(v, o);
    return v;
}

#define XB_TMO      128
#define XB_XCNT(j)  (256  + 64 * (j))
#define XB_XSUB(j)  (1280 + 64 * (j))
#define XB_XGEN(j)  (2304 + 64 * (j))
#define XB_TOP      3328
#define XB_TOPGEN   3392
#define XCD_BAR_WORDS 3456
#define XB_SPIN_CAP (1u << 22)
__device__ __forceinline__ unsigned xb_ld(unsigned* p)              { return __hip_atomic_load(p, __ATOMIC_RELAXED, __HIP_MEMORY_SCOPE_AGENT); }
__device__ __forceinline__ unsigned xb_add(unsigned* p, unsigned v) { return __hip_atomic_fetch_add(p, v, __ATOMIC_RELAXED, __HIP_MEMORY_SCOPE_AGENT); }
__device__ __forceinline__ unsigned xb_xcc_id() { return (unsigned)__builtin_amdgcn_s_getreg((3 << 11) | 20) & 0xFu; }
#define XB_SPIN(cond, bar) do { unsigned _sp = 0; while (cond) { __builtin_amdgcn_s_sleep(1); \
    if ((++_sp & 255u) == 0u) { if (xb_ld(&(bar)[XB_TMO])) break; if (_sp > XB_SPIN_CAP) { atomicAdd(&(bar)[XB_TMO], 1u); break; } } } } while (0)
struct XcdBarrier { unsigned* bar; unsigned x; volatile LAS unsigned* st; };
__device__ __forceinline__ XcdBarrier xcd_barrier_post(unsigned* bar, volatile LAS unsigned* st) {
    XcdBarrier b; b.bar = bar; b.x = xb_xcc_id(); b.st = st;
    if (threadIdx.x == 0) (void)xb_add(&bar[XB_XCNT(b.x)], 1u);
    return b;
}
__device__ __forceinline__ void xcd_barrier_complete(unsigned* bar, unsigned x, unsigned& nloc, unsigned& nx) {
    const unsigned G = gridDim.x * gridDim.y * gridDim.z;
    unsigned sum, cnt, mine, sp = 0u;
    for (;;) {
        sum = 0u; cnt = 0u;
        for (unsigned j = 0; j < 16; ++j) { const unsigned c = xb_ld(&bar[XB_XCNT(j)]); sum += c; cnt += (c > 0u) ? 1u : 0u; }
        if (sum == G) break;
        __builtin_amdgcn_s_sleep(1);
        if ((++sp & 255u) == 0u) { if (xb_ld(&bar[XB_TMO])) break; if (sp > XB_SPIN_CAP) { atomicAdd(&bar[XB_TMO], 1u); break; } }
    }
    mine = xb_ld(&bar[XB_XCNT(x)]);
    nloc = mine > 0u ? mine : 1u; nx = cnt > 0u ? cnt : 1u;
}
__device__ __forceinline__ void xcd_barrier(const XcdBarrier& b) {
    asm volatile("s_waitcnt vmcnt(0)" ::: "memory");
    __syncthreads();
    if (threadIdx.x == 0) {
        unsigned* bar = b.bar; asm volatile("" : "+s"(bar));
        __builtin_amdgcn_s_waitcnt(0);
        unsigned nloc = b.st[0], nx = b.st[1];
        if (nloc == 0u) { xcd_barrier_complete(bar, b.x, nloc, nx); b.st[0] = nloc; b.st[1] = nx; }
        const unsigned old = xb_add(&bar[XB_XSUB(b.x)], 1u);
        const unsigned gen = old / nloc;
        if (old + 1u == (gen + 1u) * nloc) {
            __builtin_amdgcn_fence(__ATOMIC_RELEASE, "agent");
            asm volatile("s_waitcnt vmcnt(0)" ::: "memory");
            const unsigned og = xb_add(&bar[XB_TOP], 1u);
            const unsigned tg = og / nx;
            if (og + 1u == (tg + 1u) * nx) xb_add(&bar[XB_TOPGEN], 1u);
            else XB_SPIN(xb_ld(&bar[XB_TOPGEN]) == tg, bar);
            __builtin_amdgcn_fence(__ATOMIC_ACQUIRE, "agent");
            xb_add(&bar[XB_XGEN(b.x)], 1u);
            asm volatile("s_waitcnt vmcnt(0)" ::: "memory");
        } else {
            XB_SPIN(xb_ld(&bar[XB_XGEN(b.x)]) == gen, bar);
            __builtin_amdgcn_fence(__ATOMIC_ACQUIRE, "agent");
            asm volatile("s_waitcnt vmcnt(0)" ::: "memory");
        }
    }
    __syncthreads();
}

namespace pg8 {
constexpr int BM = 256, BK = 64, HALF = 128, HTB = HALF * BK * 2, STAGE_BYTES = 8 * HTB, NXCD = 8, WGM = 4;
__host__ __device__ __forceinline__ int lds_byte(int r, int c) { const int st = (r >> 4) * 2 + (c >> 5), rr = r & 15, cc = c & 31, ob = rr * 64 + cc * 2; return st * 1024 + (ob ^ (((ob >> 9) & 1) << 5)); }
__host__ __device__ __forceinline__ void stage_rc(int b, int& R, int& C) { const int st = b / 1024, sb = b % 1024, swz = sb ^ (((sb >> 9) & 1) << 5); R = (st >> 1) * 16 + swz / 64; C = (st & 1) * 32 + (swz % 64) / 2; }
__host__ __device__ __forceinline__ int perm32(int rho) { const int n = rho >> 4, i = rho & 15; return 8 * (i >> 2) + 4 * n + (i & 3); }

struct UnitD { const char* A; const char* B; unsigned lda, ldb; int nt, pm, pn, tag; };

__device__ __forceinline__ void static_tile(int L, int nM, int nN, int& pm, int& pn, int rev = 0) {
    const int nwg = nM * nN; int wgid = L;
    { const int q = nwg / NXCD, r = nwg % NXCD, xcd = wgid % NXCD, len = xcd < r ? q + 1 : q; int off = wgid / NXCD; if (rev) off = len - 1 - off; wgid = (xcd < r ? xcd * (q + 1) : r * (q + 1) + (xcd - r) * q) + off; }
    const int nig = WGM * nN, gid = wgid / nig, fm = gid * WGM, gsz = (nM - fm) < WGM ? (nM - fm) : WGM;
    pm = fm + ((wgid % nig) % gsz); pn = (wgid % nig) / gsz;
}

template <class Epi, class Sched>
__device__ __forceinline__ void gemm_phase(LAS unsigned char* lds, const Sched& S, const Epi& E) {
    int tid = threadIdx.x; asm volatile("" : "+v"(tid));
    const int wid = __builtin_amdgcn_readfirstlane(tid >> 6), lane = tid & 63, wr = wid >> 2, wc = wid & 3, fr = lane & 15, fq = lane >> 4;
    int R0, C0, R1, C1; stage_rc(tid * 16, R0, C0); stage_rc(tid * 16 + 8192, R1, C1);
    const int Rb0 = Epi::PERM ? ((R0 & ~31) + perm32(R0 & 31)) : R0, Rb1 = Epi::PERM ? ((R1 & ~31) + perm32(R1 & 31)) : R1;
    const unsigned ldsw = (unsigned)wid * 1024u;
    const int aoff = lds_byte(wr * 64 + fr, fq * 8), boff = lds_byte(wc * 32 + fr, fq * 8);
#define PG8_SA(b, h) (((b) * 2 + (h)) * HTB)
#define PG8_SB(b, h) ((4 + (b) * 2 + (h)) * HTB)
#define PG8_STAGE(bufoff, gbase, v0, v1) do { \
        __builtin_amdgcn_global_load_lds((const unsigned*)((const char*)(gbase) + (v0)), (LAS unsigned*)(lds + (bufoff) + ldsw), 16, 0, 0); \
        __builtin_amdgcn_global_load_lds((const unsigned*)((const char*)(gbase) + (v1)), (LAS unsigned*)(lds + (bufoff) + ldsw + 8192), 16, 0, 0); } while (0)
#define PG8_LDA(dst, b, h) do { _Pragma("unroll") for (int m = 0; m < 4; ++m) _Pragma("unroll") for (int k = 0; k < 2; ++k) dst[m][k] = *(const LAS bf16x8*)(lds + PG8_SA(b, h) + aoff + m * 2048 + k * 1024); } while (0)
#define PG8_LDB(dst, b, h) do { _Pragma("unroll") for (int n = 0; n < 2; ++n) _Pragma("unroll") for (int k = 0; k < 2; ++k) dst[n][k] = *(const LAS bf16x8*)(lds + PG8_SB(b, h) + boff + n * 2048 + k * 1024); } while (0)
#define PG8_MMA(ai, bj, At, Bt) do { __builtin_amdgcn_s_setprio(1); _Pragma("unroll") for (int m = 0; m < 4; ++m) _Pragma("unroll") for (int n = 0; n < 2; ++n) _Pragma("unroll") for (int k = 0; k < 2; ++k) \
        acc[ai][bj][m][n] = __builtin_amdgcn_mfma_f32_16x16x32_bf16(Bt[n][k], At[m][k], acc[ai][bj][m][n], 0, 0, 0); __builtin_amdgcn_s_setprio(0); } while (0)
#define PG8_WAIT_V(n) asm volatile("s_waitcnt vmcnt(" #n ")" ::: "memory")
#define PG8_WAIT_L(n) asm volatile("s_waitcnt lgkmcnt(" #n ")" ::: "memory")
#define PG8_BAR __builtin_amdgcn_s_barrier()
#define PG8_SCHED __builtin_amdgcn_sched_barrier(0)
    UnitD cur, nxt; int ui = 0;
    if (!S.get(0, cur)) return;
    f32x4 acc[2][2][4][2];
#pragma unroll
    for (int a = 0; a < 2; ++a)
#pragma unroll
        for (int b = 0; b < 2; ++b)
#pragma unroll
            for (int m = 0; m < 4; ++m)
#pragma unroll
                for (int n = 0; n < 2; ++n) acc[a][b][m][n] = (f32x4){0.f, 0.f, 0.f, 0.f};
    bf16x8 At[4][2], B0[2][2], B1[2][2];
    const size_t kstep = (size_t)(BK * 2);
    unsigned cvA0 = (unsigned)R0 * cur.lda + (unsigned)C0 * 2u, cvA1 = (unsigned)R1 * cur.lda + (unsigned)C1 * 2u;
    unsigned cvB0 = (unsigned)Rb0 * cur.ldb + (unsigned)C0 * 2u, cvB1 = (unsigned)Rb1 * cur.ldb + (unsigned)C1 * 2u;
    {
        const char* cA = cur.A; const char* cB = cur.B; const size_t hA = (size_t)HALF * cur.lda, hB = (size_t)HALF * cur.ldb;
        PG8_STAGE(PG8_SB(0, 0), cB, cvB0, cvB1); PG8_STAGE(PG8_SB(0, 1), cB + hB, cvB0, cvB1); PG8_STAGE(PG8_SA(0, 0), cA, cvA0, cvA1); PG8_STAGE(PG8_SA(0, 1), cA + hA, cvA0, cvA1);
        if (wr == 1) PG8_BAR;
        PG8_WAIT_V(2); PG8_BAR;
        PG8_STAGE(PG8_SB(1, 0), cB + kstep, cvB0, cvB1); PG8_STAGE(PG8_SA(1, 0), cA + kstep, cvA0, cvA1); PG8_STAGE(PG8_SB(1, 1), cB + hB + kstep, cvB0, cvB1);
        PG8_WAIT_V(6); PG8_BAR;
    }
    for (;;) {
        const bool has_next = S.get(ui + 1, nxt);
        if (!has_next) nxt = cur;
        const unsigned nvA0 = (unsigned)R0 * nxt.lda + (unsigned)C0 * 2u, nvA1 = (unsigned)R1 * nxt.lda + (unsigned)C1 * 2u;
        const unsigned nvB0 = (unsigned)Rb0 * nxt.ldb + (unsigned)C0 * 2u, nvB1 = (unsigned)Rb1 * nxt.ldb + (unsigned)C1 * 2u;
        const char* cA = cur.A; const char* cB = cur.B; const size_t hAc = (size_t)HALF * cur.lda;
        const int nt = cur.nt;
        for (int t = 0; t < nt; t += 2) {
            const bool last = (t == nt - 2);
            const char* a1 = cA + (size_t)(t + 1) * kstep;
            const char* a2 = last ? nxt.A : cA + (size_t)(t + 2) * kstep; const char* b2 = last ? nxt.B : cB + (size_t)(t + 2) * kstep;
            const char* a3 = a2 + kstep; const char* b3 = b2 + kstep;
            const unsigned vA0 = last ? nvA0 : cvA0, vA1 = last ? nvA1 : cvA1, vB0 = last ? nvB0 : cvB0, vB1 = last ? nvB1 : cvB1;
            const size_t hA2 = (size_t)HALF * (last ? nxt.lda : cur.lda), hB2 = (size_t)HALF * (last ? nxt.ldb : cur.ldb);
            PG8_LDB(B0, 0, 0); PG8_LDB(B1, 0, 1); PG8_SCHED; PG8_LDA(At, 0, 0); PG8_STAGE(PG8_SA(1, 1), a1 + hAc, cvA0, cvA1);
            PG8_WAIT_V(8); PG8_WAIT_L(0); PG8_BAR; PG8_MMA(0, 0, At, B0); PG8_MMA(0, 1, At, B1); PG8_BAR; PG8_SCHED;
            PG8_LDA(At, 0, 1); PG8_STAGE(PG8_SB(0, 0), b2, vB0, vB1); PG8_STAGE(PG8_SB(0, 1), b2 + hB2, vB0, vB1); PG8_STAGE(PG8_SA(0, 0), a2, vA0, vA1);
            PG8_WAIT_V(8); PG8_WAIT_L(0); PG8_BAR; PG8_MMA(1, 0, At, B0); PG8_MMA(1, 1, At, B1); PG8_BAR; PG8_SCHED;
            PG8_LDB(B0, 1, 0); PG8_LDB(B1, 1, 1); PG8_SCHED; PG8_LDA(At, 1, 0); PG8_STAGE(PG8_SA(0, 1), a2 + hA2, vA0, vA1);
            PG8_WAIT_V(8); PG8_WAIT_L(0); PG8_BAR; PG8_MMA(0, 0, At, B0); PG8_MMA(0, 1, At, B1); PG8_BAR; PG8_SCHED;
            PG8_LDA(At, 1, 1); PG8_STAGE(PG8_SB(1, 0), b3, vB0, vB1); PG8_STAGE(PG8_SB(1, 1), b3 + hB2, vB0, vB1); PG8_STAGE(PG8_SA(1, 0), a3, vA0, vA1);
            PG8_WAIT_V(8); PG8_WAIT_L(0); PG8_BAR; PG8_MMA(1, 0, At, B0); PG8_MMA(1, 1, At, B1); PG8_BAR; PG8_SCHED;
        }
        if (Epi::KIND != 1 && wr == 0) PG8_BAR;
        { int fr2 = fr, fq2 = fq; asm volatile("" : "+v"(fr2), "+v"(fq2));
          E(acc, cur, wr, wc, fr2, fq2);
        }
        if (!has_next) break;
#pragma unroll
        for (int a = 0; a < 2; ++a)
#pragma unroll
            for (int b = 0; b < 2; ++b)
#pragma unroll
                for (int m = 0; m < 4; ++m)
#pragma unroll
                    for (int n = 0; n < 2; ++n) acc[a][b][m][n] = (f32x4){0.f, 0.f, 0.f, 0.f};
        cur = nxt; cvA0 = nvA0; cvA1 = nvA1; cvB0 = nvB0; cvB1 = nvB1; ++ui;
        if (Epi::KIND != 1 && wr == 1) PG8_BAR;
    }
    if (Epi::KIND == 1 && wr == 0) PG8_BAR;
    PG8_WAIT_V(0);
    PG8_BAR;
#undef PG8_SA
#undef PG8_SB
#undef PG8_STAGE
#undef PG8_LDA
#undef PG8_LDB
#undef PG8_MMA
#undef PG8_WAIT_V
#undef PG8_WAIT_L
#undef PG8_BAR
#undef PG8_SCHED
}
}
using pg8::UnitD;

__device__ __forceinline__ int lat_tile(int i) { return (i >> 4) * TPB + 1 + (i & 15); }
__device__ __forceinline__ int tile_mrow(int pm) { return (pm % TPB == 0) ? NB : pm / TPB; }

struct SchedStd {
    const char* A; const char* B; unsigned lda, ldb; int nt, nM, nN, G, c, lat, rev; int off = 0, lim = 1 << 30;
    __device__ __forceinline__ bool get(int i, UnitD& u) const {
        const long L = (long)i * G + c + off; if (L >= (long)nM * nN || L >= (long)lim) return false;
        int pm, pn; pg8::static_tile((int)L, nM, nN, pm, pn, rev); if (lat == 1) pm = lat_tile(pm); else if (lat == 2) pm = pm * TPB;
        u.A = A + (size_t)pm * 256 * lda; u.B = B + (size_t)pn * 256 * ldb; u.lda = lda; u.ldb = ldb; u.nt = nt; u.pm = pm; u.pn = pn; u.tag = 0; return true;
    }
};
struct SchedMlaUp {
    const char* ZA; const char* Wuq; const char* Wukv; int nM, G, c, lat;
    __device__ __forceinline__ bool get(int i, UnitD& u) const {
        const int n0 = nM * 6, n1 = nM * 8; int L;
        const int nq = (n0 - c + G - 1) / G;
        if (i < nq) L = i * G + c;
        else { const int j = i - nq, q4 = n0 - (n0 / G) * G;
            if (G == 256 && nM == NTM) { if (c < q4) { if (j >= 1) return false; L = n0 + c; } else { if (j >= 5) return false; L = n0 + q4 + (c - q4) * 5 + j; } if (L >= n0 + n1) return false; }
            else { L = n0 + j * G + c; if (L >= n0 + n1) return false; } }
        int pm, pn;
        if (L < n0) { pg8::static_tile(L, nM, 6, pm, pn); if (lat) pm = lat_tile(pm); u.A = ZA + (size_t)pm * 256 * 4096; u.B = Wuq + (size_t)pn * 256 * 3072; u.ldb = 3072; u.nt = 24; u.tag = 0; }
        else { pg8::static_tile(L - n0, nM, 8, pm, pn); if (lat) pm = lat_tile(pm); u.A = ZA + (size_t)pm * 256 * 4096 + 1536 * 2; u.B = Wukv + (size_t)pn * 256 * 1024; u.ldb = 1024; u.nt = 8; u.tag = 1; }
        u.lda = 4096; u.pm = pm; u.pn = pn; return true;
    }
};
struct SchedMerge {
    const char* ws; int nM, G, c, lat;
    __device__ __forceinline__ bool get(int i, UnitD& u) const {
        const int su = i / 6, tag = i - su * 6, L = su * G + c; if (L >= nM * 8) return false;
        int pm, pn; pg8::static_tile(L, nM, 8, pm, pn); if (lat == 1) pm = lat_tile(pm); else if (lat == 2) pm = pm * TPB;
        const int n = tag >> 1;
        if (tag & 1) { const size_t bro = WS_AR + (n == 0 ? AR_OMLA : (n == 1 ? AR_BRS5 : AR_OGQA));
            u.A = ws + bro + (size_t)pm * 256 * 2048; u.lda = 2048; u.B = ws + WS_WB + WB_WBR * 2 + ((size_t)n * 2048 + pn * 256) * 2048; u.ldb = 2048; u.nt = 16; }
        else { u.A = ws + WS_H + (size_t)pm * 256 * 4096; u.lda = 4096; u.B = ws + WS_WB + WB_WG * 2 + ((size_t)n * 2048 + pn * 256) * 4096; u.ldb = 4096; u.nt = 32; }
        u.pm = pm; u.pn = pn; u.tag = tag; return true;
    }
};
struct SchedS5 {
    const char* UgS; const char* W; unsigned ldb; int nt, G, c;
    __device__ __forceinline__ bool get(int i, UnitD& u) const {
        const int L = i * G + c; if (L >= 64 * 9) return false;
        const int g = L / 9, mt = L - g * 9;
        u.A = UgS + ((size_t)g * CHRP + mt * 256) * 1024; u.lda = 1024; u.B = W + (size_t)g * 256 * ldb; u.ldb = ldb; u.nt = nt; u.pm = g; u.pn = mt; u.tag = 0; return true;
    }
};

#define ACC_T const f32x4 (&acc)[2][2][4][2]
struct EpiUp {
    static constexpr bool PERM = true; static constexpr int KIND = 1; bf16_t* HID;
    __device__ __forceinline__ void operator()(ACC_T, const UnitD& u, int wr, int wc, int fr, int fq) const {
        const int row0 = u.pm * 256 + wr * 64 + fr, col0 = u.pn * 128 + wc * 32 + 8 * fq;
#pragma unroll
        for (int ai = 0; ai < 2; ++ai)
#pragma unroll
            for (int m = 0; m < 4; ++m) {
                const f32x4 g0 = acc[ai][0][m][0], g1 = acc[ai][0][m][1], u0 = acc[ai][1][m][0], u1 = acc[ai][1][m][1];
                u32x4 w; w.x = cvt_pk_bf16(siluf_(g0[0]) * u0[0], siluf_(g0[1]) * u0[1]); w.y = cvt_pk_bf16(siluf_(g0[2]) * u0[2], siluf_(g0[3]) * u0[3]);
                w.z = cvt_pk_bf16(siluf_(g1[0]) * u1[0], siluf_(g1[1]) * u1[1]); w.w = cvt_pk_bf16(siluf_(g1[2]) * u1[2], siluf_(g1[3]) * u1[3]);
                *(u32x4*)(HID + (size_t)(row0 + ai * 128 + m * 16) * DFFP + col0) = w; }
    }
};
struct EpiRes {
    static constexpr bool PERM = true; static constexpr int KIND = 0; f16_t* X; const float* xin; const float* cin; const float* modl; int midx; float coef; int first; int noop;
    __device__ __forceinline__ void operator()(ACC_T, const UnitD& u, int wr, int wc, int fr, int fq) const {
        if (noop) return;
        const int b = u.pm / TPB, j = u.pm - b * TPB;
        f16_t* dst = X + (size_t)u.pm * 256 * DM;
        const float* mv = modl + ((size_t)(j == 0 ? NB : b) * NMODV + midx) * DM;
        const int rl0 = wr * 64 + fr, col0 = u.pn * 256 + wc * 32 + 8 * fq;
        f32x4 mvv[2][2];
#pragma unroll
        for (int bj = 0; bj < 2; ++bj)
#pragma unroll
            for (int n = 0; n < 2; ++n) mvv[bj][n] = *(const f32x4*)(mv + col0 + bj * 128 + 4 * n) * coef;
        if (first) {
            const float* src = j == 0 ? cin + (size_t)b * CTXL * DM : xin + ((size_t)b * SEQ + (j - 1) * 256) * DM;
#pragma unroll
            for (int ai = 0; ai < 2; ++ai)
#pragma unroll
                for (int bj = 0; bj < 2; ++bj) {
                    f32x4 xs[4][2];
#pragma unroll
                    for (int m = 0; m < 4; ++m)
#pragma unroll
                        for (int n = 0; n < 2; ++n) xs[m][n] = *(const f32x4*)(src + (size_t)(rl0 + ai * 128 + m * 16) * DM + col0 + bj * 128 + 4 * n);
#pragma unroll
                    for (int m = 0; m < 4; ++m)
                        *(u32x4*)(dst + (size_t)(rl0 + ai * 128 + m * 16) * DM + col0 + bj * 128) = f8h(xs[m][0] + mvv[bj][0] * acc[ai][bj][m][0], xs[m][1] + mvv[bj][1] * acc[ai][bj][m][1]);
                    asm volatile("" ::: "memory");
                }
        } else {
#pragma unroll
            for (int ai = 0; ai < 2; ++ai) {
                u32x4 xs[4][2];
#pragma unroll
                for (int m = 0; m < 4; ++m)
#pragma unroll
                    for (int bj = 0; bj < 2; ++bj) xs[m][bj] = *(const u32x4*)(dst + (size_t)(rl0 + ai * 128 + m * 16) * DM + col0 + bj * 128);
#pragma unroll
                for (int m = 0; m < 4; ++m)
#pragma unroll
                    for (int bj = 0; bj < 2; ++bj) { f32x4 x0, x1; h8f(xs[m][bj], x0, x1);
                        *(u32x4*)(dst + (size_t)(rl0 + ai * 128 + m * 16) * DM + col0 + bj * 128) = f8h(x0 + mvv[bj][0] * acc[ai][bj][m][0], x1 + mvv[bj][1] * acc[ai][bj][m][1]); }
                asm volatile("" ::: "memory");
            }
        }
    }
};
struct EpiWin {
    static constexpr bool PERM = true; static constexpr int KIND = 0; bf16_t *ZA, *UGS, *GQ, *GKV, *KR;
    __device__ __forceinline__ void operator()(ACC_T, const UnitD& u, int wr, int wc, int fr, int fq) const {
        const int pn = u.pn, row0 = u.pm * 256 + wr * 64 + fr, cw = wc * 32 + 8 * fq;
        const int b = u.pm / TPB, ch0 = (u.pm - b * TPB) * 16 + 4 * wr;
#pragma unroll
        for (int ai = 0; ai < 2; ++ai)
#pragma unroll
            for (int m = 0; m < 4; ++m)
#pragma unroll
                for (int bj = 0; bj < 2; ++bj) {
                    const f32x4 v0 = acc[ai][bj][m][0], v1 = acc[ai][bj][m][1];
                    u32x4 w; w.x = cvt_pk_bf16(v0[0], v0[1]); w.y = cvt_pk_bf16(v0[2], v0[3]); w.z = cvt_pk_bf16(v1[0], v1[1]); w.w = cvt_pk_bf16(v1[2], v1[3]);
                    const int r = row0 + ai * 128 + m * 16, ct = bj * 128 + cw;
                    if (pn < 8) *(u32x4*)(ZA + (size_t)r * 2048 + pn * 256 + ct) = w;
                    else if (pn < 12) { const int cu = (pn - 8) * 256 + ct, g = cu >> 4, h0 = cu & 15, cr = b * NCH + ch0 + 8 * ai + m;
                        *(u32x4*)(UGS + ((size_t)g * CHRP + cr) * 512 + fr * 16 + h0) = w; }
                    else if (pn < 16) *(u32x4*)(GQ + (size_t)r * 1024 + (pn - 12) * 256 + ct) = w;
                    else if (pn < 18) *(u32x4*)(GKV + (size_t)r * 512 + (pn - 16) * 256 + ct) = w;
                    else if (ct < 64) *(u32x4*)(KR + (size_t)r * 64 + ct) = w;
                }
    }
};
struct EpiMlaUp {
    static constexpr bool PERM = true; static constexpr int KIND = 0; bf16_t *Q, *KV; const float* RS;
    __device__ __forceinline__ void operator()(ACC_T, const UnitD& u, int wr, int wc, int fr, int fq) const {
        const int row0 = u.pm * 256 + wr * 64 + fr, col0 = u.pn * 256 + wc * 32 + 8 * fq, tag = u.tag;
        bf16_t* O = tag ? KV : Q; const int ldc = tag ? 2048 : 1536;
#pragma unroll
        for (int ai = 0; ai < 2; ++ai)
#pragma unroll
            for (int m = 0; m < 4; ++m) { const int r = row0 + ai * 128 + m * 16; const float s = RS[(size_t)r * 2 + tag];
#pragma unroll
                for (int bj = 0; bj < 2; ++bj) { const f32x4 v0 = acc[ai][bj][m][0] * s, v1 = acc[ai][bj][m][1] * s;
                    u32x4 w; w.x = cvt_pk_bf16(v0[0], v0[1]); w.y = cvt_pk_bf16(v0[2], v0[3]); w.z = cvt_pk_bf16(v1[0], v1[1]); w.w = cvt_pk_bf16(v1[2], v1[3]);
                    *(u32x4*)(O + (size_t)r * ldc + col0 + bj * 128) = w; } }
    }
};
struct EpiGlu {
    static constexpr bool PERM = true; static constexpr int KIND = 0; bf16_t* BR; const bf16_t* YS; const float* bias;
    __device__ __forceinline__ void operator()(ACC_T, const UnitD& u, int wr, int wc, int fr, int fq) const {
        const int row0 = u.pm * 256 + wr * 64 + fr, col0 = u.pn * 256 + wc * 32 + 8 * fq;
        f32x4 bv[2][2];
#pragma unroll
        for (int bj = 0; bj < 2; ++bj)
#pragma unroll
            for (int n = 0; n < 2; ++n) bv[bj][n] = *(const f32x4*)(bias + col0 + bj * 128 + 4 * n);
#pragma unroll
        for (int ai = 0; ai < 2; ++ai)
#pragma unroll
            for (int m = 0; m < 4; ++m) { const size_t ro = (size_t)(row0 + ai * 128 + m * 16) * 1024 + col0;
#pragma unroll
                for (int bj = 0; bj < 2; ++bj) { const u32x4 y = *(const u32x4*)(YS + ro + bj * 128);
                    const f32x4 a0 = acc[ai][bj][m][0] + bv[bj][0], a1 = acc[ai][bj][m][1] + bv[bj][1];
                    u32x4 w; w.x = cvt_pk_bf16(bf_lo(y.x) * sigmoidf_(a0[0]), bf_hi(y.x) * sigmoidf_(a0[1])); w.y = cvt_pk_bf16(bf_lo(y.y) * sigmoidf_(a0[2]), bf_hi(y.y) * sigmoidf_(a0[3]));
                    w.z = cvt_pk_bf16(bf_lo(y.z) * sigmoidf_(a1[0]), bf_hi(y.z) * sigmoidf_(a1[1])); w.w = cvt_pk_bf16(bf_lo(y.w) * sigmoidf_(a1[2]), bf_hi(y.w) * sigmoidf_(a1[3]));
                    *(u32x4*)(BR + ro + bj * 128) = w; } }
    }
};
struct EpiMerge {
    static constexpr bool PERM = true; static constexpr int KIND = 0; bf16_t* Y; unsigned char* GS; const float* bgate;
    __device__ __forceinline__ void operator()(ACC_T, const UnitD& u, int wr, int wc, int fr, int fq) const {
        const int tag = u.tag, n_ = tag >> 1, row0 = u.pm * 256 + wr * 64 + fr, col0 = u.pn * 256 + wc * 32 + 8 * fq;
        unsigned char* gs = GS + (size_t)blockIdx.x * 131072 + (size_t)(((wr * 4 + wc) * 4 + fq) * 16 + fr) * 16;
        if (!(tag & 1)) {
            f32x4 bv[2][2];
#pragma unroll
            for (int bj = 0; bj < 2; ++bj)
#pragma unroll
                for (int n = 0; n < 2; ++n) bv[bj][n] = *(const f32x4*)(bgate + n_ * DM + col0 + bj * 128 + 4 * n);
#pragma unroll
            for (int ai = 0; ai < 2; ++ai)
#pragma unroll
                for (int m = 0; m < 4; ++m)
#pragma unroll
                    for (int bj = 0; bj < 2; ++bj) { const f32x4 a0 = acc[ai][bj][m][0] + bv[bj][0], a1 = acc[ai][bj][m][1] + bv[bj][1];
                        u32x4 w; w.x = cvt_pk_bf16(sigmoidf_(a0[0]), sigmoidf_(a0[1])); w.y = cvt_pk_bf16(sigmoidf_(a0[2]), sigmoidf_(a0[3]));
                        w.z = cvt_pk_bf16(sigmoidf_(a1[0]), sigmoidf_(a1[1])); w.w = cvt_pk_bf16(sigmoidf_(a1[2]), sigmoidf_(a1[3]));
                        *(u32x4*)(gs + (size_t)((ai * 4 + m) * 2 + bj) * 8192) = w; asm volatile("" ::: "memory");
                    }
        } else {
#pragma unroll
            for (int ai = 0; ai < 2; ++ai)
#pragma unroll
                for (int mh = 0; mh < 2; ++mh) {
                    u32x4 g[2][2], p[2][2];
#pragma unroll
                    for (int mm = 0; mm < 2; ++mm)
#pragma unroll
                        for (int bj = 0; bj < 2; ++bj) { const int m = mh * 2 + mm;
                            g[mm][bj] = *(const u32x4*)(gs + (size_t)((ai * 4 + m) * 2 + bj) * 8192);
                            if (n_ > 0) p[mm][bj] = *(const u32x4*)(Y + (size_t)(row0 + ai * 128 + m * 16) * DM + col0 + bj * 128); }
#pragma unroll
                    for (int mm = 0; mm < 2; ++mm)
#pragma unroll
                        for (int bj = 0; bj < 2; ++bj) { const int m = mh * 2 + mm; const u32x4 gg = g[mm][bj];
                            const f32x4 a0 = acc[ai][bj][m][0], a1 = acc[ai][bj][m][1];
                            f32x4 y0 = (f32x4){bf_lo(gg.x) * a0[0], bf_hi(gg.x) * a0[1], bf_lo(gg.y) * a0[2], bf_hi(gg.y) * a0[3]};
                            f32x4 y1 = (f32x4){bf_lo(gg.z) * a1[0], bf_hi(gg.z) * a1[1], bf_lo(gg.w) * a1[2], bf_hi(gg.w) * a1[3]};
                            if (n_ > 0) { const u32x4 pp = p[mm][bj];
                                y0 += (f32x4){bf_lo(pp.x), bf_hi(pp.x), bf_lo(pp.y), bf_hi(pp.y)}; y1 += (f32x4){bf_lo(pp.z), bf_hi(pp.z), bf_lo(pp.w), bf_hi(pp.w)}; }
                            u32x4 w; w.x = cvt_pk_bf16(y0[0], y0[1]); w.y = cvt_pk_bf16(y0[2], y0[3]); w.z = cvt_pk_bf16(y1[0], y1[1]); w.w = cvt_pk_bf16(y1[2], y1[3]);
                            *(u32x4*)(Y + (size_t)(row0 + ai * 128 + m * 16) * DM + col0 + bj * 128) = w; }
                    asm volatile("" ::: "memory");
                }
        }
    }
};
struct EpiS5A {
    static constexpr bool PERM = true; static constexpr int KIND = 0; bf16_t* E;
    __device__ __forceinline__ void operator()(ACC_T, const UnitD& u, int wr, int wc, int fr, int fq) const {
        bf16_t* base = E + ((size_t)u.pm * CHRP + u.pn * 256 + wr * 64 + fr) * 256 + wc * 32 + 8 * fq;
#pragma unroll
        for (int ai = 0; ai < 2; ++ai)
#pragma unroll
            for (int m = 0; m < 4; ++m)
#pragma unroll
                for (int bj = 0; bj < 2; ++bj) { const f32x4 v0 = acc[ai][bj][m][0], v1 = acc[ai][bj][m][1];
                    u32x4 w; w.x = cvt_pk_bf16(v0[0], v0[1]); w.y = cvt_pk_bf16(v0[2], v0[3]); w.z = cvt_pk_bf16(v1[0], v1[1]); w.w = cvt_pk_bf16(v1[2], v1[3]);
                    *(u32x4*)(base + (size_t)(ai * 128 + m * 16) * 256 + bj * 128) = w; }
    }
};
struct EpiS5C {
    static constexpr bool PERM = true; static constexpr int KIND = 0; bf16_t *YS, *GEL;
    __device__ __forceinline__ void operator()(ACC_T, const UnitD& u, int wr, int wc, int fr, int fq) const {
        const int g = u.pm;
#pragma unroll
        for (int ai = 0; ai < 2; ++ai)
#pragma unroll
            for (int m = 0; m < 4; ++m) { const int cr = u.pn * 256 + ai * 128 + wr * 64 + m * 16 + fr;
                if (cr < CHR) { const int b = cr / NCH, c = cr - b * NCH;
#pragma unroll
                    for (int bj = 0; bj < 2; ++bj) { const int n8 = bj * 128 + wc * 32 + 8 * fq, i = n8 >> 4, ho = n8 & 15;
                        const size_t o = ((size_t)b * TOK + c * 16 + i) * 1024 + g * 16 + ho;
                        const f32x4 v0 = acc[ai][bj][m][0], v1 = acc[ai][bj][m][1];
                        u32x4 w; w.x = cvt_pk_bf16(v0[0], v0[1]); w.y = cvt_pk_bf16(v0[2], v0[3]); w.z = cvt_pk_bf16(v1[0], v1[1]); w.w = cvt_pk_bf16(v1[2], v1[3]);
                        *(u32x4*)(YS + o) = w;
                        w.x = cvt_pk_bf16(gelu_tanh_(v0[0]), gelu_tanh_(v0[1])); w.y = cvt_pk_bf16(gelu_tanh_(v0[2]), gelu_tanh_(v0[3]));
                        w.z = cvt_pk_bf16(gelu_tanh_(v1[0]), gelu_tanh_(v1[1])); w.w = cvt_pk_bf16(gelu_tanh_(v1[2]), gelu_tanh_(v1[3]));
                        *(u32x4*)(GEL + o) = w; } } }
    }
};

namespace att {
constexpr int NW = 8, QBLK = 32, KVBLK = 64;
constexpr float THR = 8.f;
constexpr size_t SHM_V = KVBLK * 128 * 2, SHM_K = KVBLK * 128 * 2, SHM_KR = KVBLK * 64 * 2;
constexpr size_t OFF_V = 0, OFF_K = 3 * SHM_V, OFF_KR = OFF_K + 2 * SHM_K, OFF_WS = OFF_KR + 2 * SHM_KR, OFF_QR = OFF_WS + NW * 64 * 4, SHM_ATTN = OFF_QR + NW * 4096;
#define KSWZ(row, colB) ((row) * 256 + ((colB) ^ (((row) & 7) << 4)))
#define KRSWZ(row, colB) ((row) * 128 + ((colB) ^ ((((row) >> 1) & 7) << 4)))
#define SBAR() __builtin_amdgcn_sched_barrier(0)
__device__ __forceinline__ int crow(int r, int hi) { return (r & 3) + 8 * (r >> 2) + 4 * hi; }

template <int SCALE_ID> struct ScaleC;
template <> struct ScaleC<0> { static constexpr float SCALE = 0.07216878364870323f; };
template <> struct ScaleC<1> { static constexpr float SCALE = 0.08838834764831845f; };

template <int SID> __device__ __forceinline__ void partialSM(f32x16& p0, f32x16& p1, float& m_reg, float& mn, float& alpha) {
    constexpr float SCALE = ScaleC<SID>::SCALE, C = SCALE * 1.4426950408889634f;
    float pmax = p0[0];
#pragma unroll
    for (int r = 1; r < 16; ++r) pmax = fmaxf(pmax, p0[r]);
#pragma unroll
    for (int r = 0; r < 16; ++r) pmax = fmaxf(pmax, p1[r]);
    { auto rr = __builtin_amdgcn_permlane32_swap(__float_as_uint(pmax), __float_as_uint(pmax), false, false);
      pmax = fmaxf(__uint_as_float(rr[0]), __uint_as_float(rr[1])); }
    if (__builtin_expect(__all(pmax - m_reg <= THR / SCALE), 1)) { mn = m_reg; alpha = 1.f; }
    else { mn = fmaxf(m_reg, pmax); alpha = __builtin_amdgcn_exp2f((m_reg - mn) * C); m_reg = mn; }
    const float mnC = -mn * C;
#pragma unroll
    for (int r = 0; r < 16; ++r) p0[r] = fmaf(p0[r], C, mnC);
#pragma unroll
    for (int r = 0; r < 16; ++r) p1[r] = fmaf(p1[r], C, mnC);
#pragma unroll
    for (int r = 0; r < 16; ++r) p0[r] = __builtin_amdgcn_exp2f(p0[r]);
}
__device__ __forceinline__ void finishSM(f32x16& p0, f32x16& p1, float alpha, float& l_reg, bf16x8& pa0, bf16x8& pa1, bf16x8& pa2, bf16x8& pa3) {
#pragma unroll
    for (int r = 0; r < 16; ++r) p1[r] = __builtin_amdgcn_exp2f(p1[r]);
    float ps = 0;
#pragma unroll
    for (int r = 0; r < 16; ++r) ps += p0[r];
#pragma unroll
    for (int r = 0; r < 16; ++r) ps += p1[r];
    { auto rr = __builtin_amdgcn_permlane32_swap(__float_as_uint(ps), __float_as_uint(ps), false, false);
      ps = __uint_as_float(rr[0]) + __uint_as_float(rr[1]); }
    l_reg = l_reg * alpha + ps;
#define PK4(P, BASE, OUT) do { unsigned a0 = cvt_pk_bf16(P[BASE + 0], P[BASE + 1]), a1 = cvt_pk_bf16(P[BASE + 2], P[BASE + 3]);   \
    unsigned b0 = cvt_pk_bf16(P[BASE + 4], P[BASE + 5]), b1 = cvt_pk_bf16(P[BASE + 6], P[BASE + 7]);                              \
    auto r0 = __builtin_amdgcn_permlane32_swap(a0, b0, false, false); auto r1 = __builtin_amdgcn_permlane32_swap(a1, b1, false, false); \
    u32x4 w = {r0[0], r1[0], r0[1], r1[1]}; OUT = *reinterpret_cast<bf16x8*>(&w); } while (0)
    PK4(p0, 0, pa0); PK4(p0, 8, pa1); PK4(p1, 0, pa2); PK4(p1, 8, pa3);
#undef PK4
}
template <bool MLA> __device__ __forceinline__ void qkt(f32x16& p0, f32x16& p1, const char* Ks, const char* KRs, const bf16x8* qr, const char* qrl, int r32, int hi) {
    p0 = f32x16{}; p1 = f32x16{};
#pragma unroll
    for (int d0 = 0; d0 < 8; ++d0) { const int cb = (d0 * 16 + hi * 8) * 2;
        const bf16x8 b0 = *reinterpret_cast<const bf16x8*>(Ks + KSWZ(r32, cb));
        const bf16x8 b1 = *reinterpret_cast<const bf16x8*>(Ks + KSWZ(32 + r32, cb));
        p0 = __builtin_amdgcn_mfma_f32_32x32x16_bf16(b0, qr[d0], p0, 0, 0, 0);
        p1 = __builtin_amdgcn_mfma_f32_32x32x16_bf16(b1, qr[d0], p1, 0, 0, 0); }
    if constexpr (MLA) {
#pragma unroll
        for (int d0 = 0; d0 < 4; ++d0) { const int cb = (d0 * 16 + hi * 8) * 2;
            const bf16x8 b0 = *reinterpret_cast<const bf16x8*>(KRs + KRSWZ(r32, cb));
            const bf16x8 b1 = *reinterpret_cast<const bf16x8*>(KRs + KRSWZ(32 + r32, cb));
            const bf16x8 qf = *reinterpret_cast<const bf16x8*>(qrl + d0 * 1024);
            p0 = __builtin_amdgcn_mfma_f32_32x32x16_bf16(b0, qf, p0, 0, 0, 0);
            p1 = __builtin_amdgcn_mfma_f32_32x32x16_bf16(b1, qf, p1, 0, 0, 0); }
    }
}
__device__ __forceinline__ int v_st(int k, int c) { const int kk = (k & ~0xC) | ((k & 4) << 1) | ((k & 8) >> 1); return ((kk >> 3) * 4 + (c >> 5)) * 512 + ((kk & 7) * 32 + (c & 31)) * 2; }
__device__ __forceinline__ int v_rd_base(int lane) { return ((lane & 3) << 3) | (((lane >> 2) & 3) << 6) | (((lane >> 4) & 1) << 5) | (((lane >> 5) & 1) << 8); }
constexpr int v_rd_off(int d0, int ks, int half) { return d0 * 512 + ks * 4096 + half * 2048; }
template <int OFF> __device__ __forceinline__ s16x4 tr_read(int vb) {
    s16x4 r; asm volatile("ds_read_b64_tr_b16 %0, %1 offset:%2" : "=&v"(r) : "v"(vb), "i"(OFF) : "memory"); return r;
}
template <int D0> __device__ __forceinline__ void pv_one(f32x16& od, int vb, bf16x8 pa0, bf16x8 pa1, bf16x8 pa2, bf16x8 pa3) {
    const s16x4 l0 = tr_read<v_rd_off(D0, 0, 0)>(vb), h0 = tr_read<v_rd_off(D0, 0, 1)>(vb), l1 = tr_read<v_rd_off(D0, 1, 0)>(vb), h1 = tr_read<v_rd_off(D0, 1, 1)>(vb);
    const s16x4 l2 = tr_read<v_rd_off(D0, 2, 0)>(vb), h2 = tr_read<v_rd_off(D0, 2, 1)>(vb), l3 = tr_read<v_rd_off(D0, 3, 0)>(vb), h3 = tr_read<v_rd_off(D0, 3, 1)>(vb);
    asm volatile("s_waitcnt lgkmcnt(0)" ::: "memory"); SBAR();
#define PK(L, H) (bf16x8){L[0], L[1], L[2], L[3], H[0], H[1], H[2], H[3]}
    od = __builtin_amdgcn_mfma_f32_32x32x16_bf16(pa0, PK(l0, h0), od, 0, 0, 0);
    od = __builtin_amdgcn_mfma_f32_32x32x16_bf16(pa1, PK(l1, h1), od, 0, 0, 0);
    od = __builtin_amdgcn_mfma_f32_32x32x16_bf16(pa2, PK(l2, h2), od, 0, 0, 0);
    od = __builtin_amdgcn_mfma_f32_32x32x16_bf16(pa3, PK(l3, h3), od, 0, 0, 0);
#undef PK
}
__device__ __forceinline__ void pv_d0(f32x16* o, int vb, bf16x8 pa0, bf16x8 pa1, bf16x8 pa2, bf16x8 pa3) {
    pv_one<0>(o[0], vb, pa0, pa1, pa2, pa3); pv_one<1>(o[1], vb, pa0, pa1, pa2, pa3); pv_one<2>(o[2], vb, pa0, pa1, pa2, pa3); pv_one<3>(o[3], vb, pa0, pa1, pa2, pa3);
}
__device__ __forceinline__ void rope_pair(bf16x8& f1, bf16x8& f2, const float* tp) {
    const u32x4 a = *reinterpret_cast<u32x4*>(&f1), b = *reinterpret_cast<u32x4*>(&f2);
    const f32x4 t0 = *(const f32x4*)(tp), t1 = *(const f32x4*)(tp + 4), t2 = *(const f32x4*)(tp + 8), t3 = *(const f32x4*)(tp + 12);
    const float c[8] = {t0[0], t0[2], t1[0], t1[2], t2[0], t2[2], t3[0], t3[2]}, s[8] = {t0[1], t0[3], t1[1], t1[3], t2[1], t2[3], t3[1], t3[3]};
    const float x1[8] = {bf_lo(a.x), bf_hi(a.x), bf_lo(a.y), bf_hi(a.y), bf_lo(a.z), bf_hi(a.z), bf_lo(a.w), bf_hi(a.w)};
    const float x2[8] = {bf_lo(b.x), bf_hi(b.x), bf_lo(b.y), bf_hi(b.y), bf_lo(b.z), bf_hi(b.z), bf_lo(b.w), bf_hi(b.w)};
    float o1[8], o2[8];
#pragma unroll
    for (int j = 0; j < 8; ++j) { o1[j] = x1[j] * c[j] - x2[j] * s[j]; o2[j] = x2[j] * c[j] + x1[j] * s[j]; }
    u32x4 wa = {cvt_pk_bf16(o1[0], o1[1]), cvt_pk_bf16(o1[2], o1[3]), cvt_pk_bf16(o1[4], o1[5]), cvt_pk_bf16(o1[6], o1[7])};
    u32x4 wb = {cvt_pk_bf16(o2[0], o2[1]), cvt_pk_bf16(o2[2], o2[3]), cvt_pk_bf16(o2[4], o2[5]), cvt_pk_bf16(o2[6], o2[7])};
    f1 = *reinterpret_cast<bf16x8*>(&wa); f2 = *reinterpret_cast<bf16x8*>(&wb);
}
struct AttnP { const bf16_t *Q, *KV, *KR, *GQ, *GKV; bf16_t *OMLA, *OGQA; const float *ROPEG, *ROPEM, *gq; };

template <bool MLA>
__device__ __forceinline__ void attn_unit(const AttnP& P, int b, int h, int qb, char* lds) {
    constexpr int SID = MLA ? 0 : 1;
    constexpr int LDQ = MLA ? 1536 : 1024, LDK = MLA ? 2048 : 512, LDO = 1024;
    int tid = threadIdx.x; asm volatile("" : "+v"(tid));
    const int wid = __builtin_amdgcn_readfirstlane(tid >> 6), lane = tid & 63, r32 = lane & 31, hi = lane >> 5;
    const size_t rowbase = (size_t)b * TOK + (size_t)qb * 256, keybase = (size_t)b * TOK;
    const int seq = qb == 0 ? CTXL : TOK;
    const bf16_t* Qb = MLA ? P.Q + rowbase * LDQ + h * 192 : P.GQ + rowbase * LDQ + h * 128;
    const bf16_t* Kh = MLA ? P.KV + keybase * LDK + h * 256 : P.GKV + keybase * LDK + (h >> 2) * 128;
    const bf16_t* Vh = MLA ? Kh + 128 : Kh + 256;
    const bf16_t* KRp = P.KR + keybase * 64;
    bf16_t* Ob = (MLA ? P.OMLA : P.OGQA) + rowbase * LDO + h * 128;
    char* V_lds = lds + OFF_V; char* K_lds = lds + OFF_K; char* KR_lds = lds + OFF_KR;
    float* ws = (float*)(lds + OFF_WS) + wid * 64; float* li_l = ws; float* al_l = ws + 32;
    char* qrl = lds + OFF_QR + wid * 4096 + lane * 16;
    float m_reg = -1e30f, l_reg = 0; f32x16 o[4] = {}; bf16x8 qr[8];
    unsigned koff0, koff1, kroff, voff0, voff1;
    { const int p0 = (wid * 2) * 64 + lane, p1 = p0 + 64;
      { const int row = p0 >> 4, c = (p0 & 15) ^ (row & 7); koff0 = (unsigned)(row * LDK + c * 8); }
      { const int row = p1 >> 4, c = (p1 & 15) ^ (row & 7); koff1 = (unsigned)(row * LDK + c * 8); }
      { const int row = wid * 8 + (lane >> 3), c = (lane & 7) ^ ((row >> 1) & 7); kroff = (unsigned)(row * 64 + c * 8); }
      { const int s_ = p0 >> 5, u_ = p0 & 31, kk = (s_ >> 2) * 8 + (u_ >> 2), k = (kk & ~0xC) | ((kk & 4) << 1) | ((kk & 8) >> 1); voff0 = (unsigned)(k * LDK + (s_ & 3) * 32 + (u_ & 3) * 8); }
      { const int s_ = p1 >> 5, u_ = p1 & 31, kk = (s_ >> 2) * 8 + (u_ >> 2), k = (kk & ~0xC) | ((kk & 4) << 1) | ((kk & 8) >> 1); voff1 = (unsigned)(k * LDK + (s_ & 3) * 32 + (u_ & 3) * 8); } }
    LAS unsigned char* ldsl = (LAS unsigned char*)lds;
    const unsigned wk = (unsigned)__builtin_amdgcn_readfirstlane(wid) * 2048u, wkr = (unsigned)__builtin_amdgcn_readfirstlane(wid) * 1024u;
#define GLDS16(gp, ldsoff) __builtin_amdgcn_global_load_lds((const unsigned*)(gp), (LAS unsigned*)(ldsl + (ldsoff)), 16, 0, 0)
#define SISSUE(k0, kb, vbo) do { const bf16_t* kt_ = Kh + (size_t)(k0) * LDK; const bf16_t* vt_ = Vh + (size_t)(k0) * LDK;                         \
    GLDS16(kt_ + koff0, OFF_K + (kb) * SHM_K + wk); GLDS16(kt_ + koff1, OFF_K + (kb) * SHM_K + wk + 1024u);                                      \
    if constexpr (MLA) GLDS16(KRp + (size_t)(k0) * 64 + kroff, OFF_KR + (kb) * SHM_KR + wkr);                                                     \
    GLDS16(vt_ + voff0, OFF_V + (vbo) + wk); GLDS16(vt_ + voff1, OFF_V + (vbo) + wk + 1024u); } while (0)
#define RESC(a) do { if (__any((a) < 1.f)) { if (hi == 0) al_l[r32] = (a); asm volatile("s_waitcnt lgkmcnt(0)" ::: "memory"); \
    _Pragma("unroll") for (int d = 0; d < 4; ++d) _Pragma("unroll") for (int r = 0; r < 16; ++r) o[d][r] *= al_l[crow(r, hi)]; } } while (0)
    const int vbl = (int)(uintptr_t)V_lds + v_rd_base(lane);
    f32x16 pA0, pA1, pB0, pB1; float mnA, mnB, alA, alB; bf16x8 pa0, pa1, pa2, pa3; const int NT = seq / KVBLK;
    unsigned vprev = 0u, vcur = (unsigned)SHM_V, vnext = 2u * (unsigned)SHM_V;
    {
        const int qrow = wid * QBLK + r32;
        const bf16_t* Qw = Qb + (size_t)qrow * LDQ + hi * 8;
#pragma unroll
        for (int d0 = 0; d0 < 8; ++d0) qr[d0] = *reinterpret_cast<const bf16x8*>(Qw + d0 * 16);
        bf16x8 q8, q9, q10, q11;
        if constexpr (MLA) { q8 = *reinterpret_cast<const bf16x8*>(Qw + 128); q9 = *reinterpret_cast<const bf16x8*>(Qw + 144); q10 = *reinterpret_cast<const bf16x8*>(Qw + 160); q11 = *reinterpret_cast<const bf16x8*>(Qw + 176); }
        SISSUE(0, 0, 0u); SISSUE(KVBLK, 1, (unsigned)SHM_V);
        const int t = (qb - 1) * 256 + qrow, prow = t >> 6, pcol = t & 63;
        if constexpr (!MLA) {
            float ss = 0.f;
#pragma unroll
            for (int d0 = 0; d0 < 8; ++d0) { const u32x4 a = *reinterpret_cast<u32x4*>(&qr[d0]);
                const float x[8] = {bf_lo(a.x), bf_hi(a.x), bf_lo(a.y), bf_hi(a.y), bf_lo(a.z), bf_hi(a.z), bf_lo(a.w), bf_hi(a.w)};
#pragma unroll
                for (int j = 0; j < 8; ++j) ss += x[j] * x[j]; }
            ss += __shfl_xor(ss, 32);
            const float rstd = rsqrtf(ss * (1.f / 128.f) + EPS);
#pragma unroll
            for (int d0 = 0; d0 < 8; ++d0) { const u32x4 a = *reinterpret_cast<u32x4*>(&qr[d0]);
                const f32x4 g0 = *(const f32x4*)(P.gq + d0 * 16 + hi * 8), g1 = *(const f32x4*)(P.gq + d0 * 16 + hi * 8 + 4);
                u32x4 w; w.x = cvt_pk_bf16(bf_lo(a.x) * rstd * g0[0], bf_hi(a.x) * rstd * g0[1]); w.y = cvt_pk_bf16(bf_lo(a.y) * rstd * g0[2], bf_hi(a.y) * rstd * g0[3]);
                w.z = cvt_pk_bf16(bf_lo(a.z) * rstd * g1[0], bf_hi(a.z) * rstd * g1[1]); w.w = cvt_pk_bf16(bf_lo(a.w) * rstd * g1[2], bf_hi(a.w) * rstd * g1[3]);
                qr[d0] = *reinterpret_cast<bf16x8*>(&w); }
            if (qb > 0) {
                const float* tr = P.ROPEG + (size_t)prow * 64 + hi * 16; const float* tc = P.ROPEG + (size_t)pcol * 64 + hi * 16;
                rope_pair(qr[0], qr[2], tr); rope_pair(qr[1], qr[3], tr + 32); rope_pair(qr[4], qr[6], tc); rope_pair(qr[5], qr[7], tc + 32);
            }
        } else {
            if (qb > 0) {
                const float* tr = P.ROPEM + (size_t)prow * 32 + hi * 16; const float* tc = P.ROPEM + (size_t)pcol * 32 + hi * 16;
                rope_pair(q8, q9, tr); rope_pair(q10, q11, tc);
            }
            *reinterpret_cast<bf16x8*>(qrl) = q8; *reinterpret_cast<bf16x8*>(qrl + 1024) = q9; *reinterpret_cast<bf16x8*>(qrl + 2048) = q10; *reinterpret_cast<bf16x8*>(qrl + 3072) = q11;
            asm volatile("s_waitcnt lgkmcnt(0)" ::: "memory");
        }
    }
    VM_WAIT(); __syncthreads();
    qkt<MLA>(pA0, pA1, K_lds, KR_lds, qr, qrl, r32, hi); partialSM<SID>(pA0, pA1, m_reg, mnA, alA);
    __syncthreads();
    for (int j = 1; j + 1 < NT; j += 2) {
        SBAR(); qkt<MLA>(pB0, pB1, K_lds + SHM_K, KR_lds + SHM_KR, qr, qrl, r32, hi);
        finishSM(pA0, pA1, alA, l_reg, pa0, pa1, pa2, pa3); SBAR();
        SISSUE((j + 1) * KVBLK, 0, vnext); SBAR();
        pv_d0(o, vbl + (int)vprev, pa0, pa1, pa2, pa3); partialSM<SID>(pB0, pB1, m_reg, mnB, alB);
        RESC(alB); VM_WAIT(); __syncthreads();
        { const unsigned t_ = vprev; vprev = vcur; vcur = vnext; vnext = t_; }
        SBAR(); qkt<MLA>(pA0, pA1, K_lds, KR_lds, qr, qrl, r32, hi);
        finishSM(pB0, pB1, alB, l_reg, pa0, pa1, pa2, pa3); SBAR();
        if (j + 2 < NT) SISSUE((j + 2) * KVBLK, 1, vnext); SBAR();
        pv_d0(o, vbl + (int)vprev, pa0, pa1, pa2, pa3); partialSM<SID>(pA0, pA1, m_reg, mnA, alA);
        RESC(alA); VM_WAIT(); __syncthreads();
        { const unsigned t_ = vprev; vprev = vcur; vcur = vnext; vnext = t_; }
    }
    SBAR(); qkt<MLA>(pB0, pB1, K_lds + SHM_K, KR_lds + SHM_KR, qr, qrl, r32, hi);
    finishSM(pA0, pA1, alA, l_reg, pa0, pa1, pa2, pa3); SBAR();
    pv_d0(o, vbl + (int)vprev, pa0, pa1, pa2, pa3); partialSM<SID>(pB0, pB1, m_reg, mnB, alB);
    RESC(alB);
    finishSM(pB0, pB1, alB, l_reg, pa0, pa1, pa2, pa3); SBAR();
    pv_d0(o, vbl + (int)vcur, pa0, pa1, pa2, pa3);
    if (hi == 0) li_l[r32] = l_reg; asm volatile("s_waitcnt lgkmcnt(0)" ::: "memory");
    float rli[16];
#pragma unroll
    for (int r = 0; r < 16; ++r) rli[r] = __builtin_amdgcn_rcpf(li_l[crow(r, hi)]);
    __syncthreads();
    int lane2 = lane; asm volatile("" : "+v"(lane2));
    const int r32b = lane2 & 31, hib = lane2 >> 5;
    char* ot = lds + (size_t)wid * (32 * 272);
#pragma unroll
    for (int r = 0; r < 16; ++r) { const int orow = crow(r, hib);
#pragma unroll
        for (int d0 = 0; d0 < 4; ++d0) *(bf16_t*)(ot + orow * 272 + (d0 * 32 + r32b) * 2) = f2bf(o[d0][r] * rli[r]); }
    asm volatile("s_waitcnt lgkmcnt(0)" ::: "memory");
#pragma unroll
    for (int it = 0; it < 8; ++it) { const int ch = it * 64 + lane2, row = ch >> 4, c16 = ch & 15;
        const u32x4 w = *(const u32x4*)(ot + row * 272 + c16 * 16);
        *(u32x4*)(Ob + (size_t)(wid * QBLK + row) * LDO + c16 * 8) = w; }
    __syncthreads();
#undef GLDS16
#undef SISSUE
#undef RESC
}
}

struct Args { const float* in[31]; float* out; unsigned char* ws; int ph_lo, ph_hi; };
typedef const __attribute__((address_space(4))) Args* KArgs;
__device__ __forceinline__ KArgs kargs() { KArgs p = (KArgs)__builtin_amdgcn_kernarg_segment_ptr(); asm volatile("" : "+s"(p)); return p; }

__device__ __forceinline__ void phase_pre(KArgs a, LAS unsigned char* lds, int G) {
    int tidx_ = threadIdx.x; asm volatile("" : "+v"(tidx_));
    const int tid = tidx_;
    const float* c = a->in[1]; const float* cctx = a->in[3]; const float* wmod = a->in[4]; const float* bmod = a->in[5];
    float* MOD = (float*)(a->ws + WS_MOD);
    LAS float* sS = (LAS float*)lds;
    LAS float* sP = (LAS float*)(lds + 73728);
    for (int i = tid; i < 9 * 2048; i += 512) { const int r = i >> 11, k = i & 2047; const float v = r < 8 ? c[r * 2048 + k] : cctx[k]; sS[i] = siluf_(v); }
    __syncthreads();
    for (int item = blockIdx.x; item < 256; item += G) {
        const int l = item >> 7, c4b = (item & 127) * 36;
        const int cq = tid % 36, ks = tid / 36;
        f32x4 accv[9];
#pragma unroll
        for (int r = 0; r < 9; ++r) accv[r] = (f32x4){0.f, 0.f, 0.f, 0.f};
        if (ks < 14) {
            const float* wp = wmod + (size_t)l * 2048 * 18432 + (size_t)(c4b + cq) * 4;
            for (int k = ks; k < 2048; k += 14 * 8) {
                f32x4 w[8];
#pragma unroll
                for (int q = 0; q < 8; ++q) { const int kk = k + 14 * q; w[q] = kk < 2048 ? *(const f32x4*)(wp + (size_t)kk * 18432) : (f32x4){0.f, 0.f, 0.f, 0.f}; }
#pragma unroll
                for (int q = 0; q < 8; ++q) { const int kk = (k + 14 * q) < 2048 ? (k + 14 * q) : 0;
#pragma unroll
                    for (int r = 0; r < 9; ++r) accv[r] += w[q] * sS[r * 2048 + kk]; } }
#pragma unroll
            for (int r = 0; r < 9; ++r) *(LAS f32x4*)(sP + ((ks * 36 + cq) * 9 + r) * 4) = accv[r];
        }
        __syncthreads();
        for (int o = tid; o < 36 * 9 * 4; o += 512) { const int cq2 = o / 36, rem = o - cq2 * 36;
            float s = 0.f;
            for (int k2 = 0; k2 < 14; ++k2) s += sP[(k2 * 36 + cq2) * 36 + rem];
            const int r = rem >> 2, e = rem & 3, col = (c4b + cq2) * 4 + e;
            MOD[((size_t)(l * 9 + r) * 9) * 2048 + col] = s + bmod[(size_t)l * 18432 + col];
        }
        __syncthreads();
    }
    float* RG = (float*)(a->ws + WS_ROPEG); float* RM = (float*)(a->ws + WS_ROPEM);
    for (int i = blockIdx.x * 512 + tid; i < 64 * 32 + 64 * 16; i += G * 512) {
        if (i < 2048) { const int pos = i >> 5, f = i & 31; const float fr = powf(10000.0f, -(float)(2 * f) / 64.0f), ang = (float)pos * fr; RG[i * 2] = cosf(ang); RG[i * 2 + 1] = sinf(ang); }
        else { const int k = i - 2048, pos = k >> 4, f = k & 15; const float fr = powf(10000.0f, -(float)(2 * f) / 32.0f), ang = (float)pos * fr; RM[k * 2] = cosf(ang); RM[k * 2 + 1] = sinf(ang); }
    }
}

__device__ __forceinline__ int conv_row_map(int kind, int n0) {
    if (kind == 1) return n0 < DFF ? (n0 >> 7) * 256 + (n0 & 127) : ((n0 - DFF) >> 7) * 256 + 128 + ((n0 - DFF) & 127);
    if (kind == 2) { if (n0 < 2048) return n0; if (n0 < 2112) return 4608 + (n0 - 2048); return n0 - 64; }
    return n0;
}
__device__ __forceinline__ void conv_item(const float* W, int K, int N, bf16_t* WT, int kind, const float* kscale, LAS float* scr, int item, int lane, int KP = 0) {
    if (KP == 0) KP = K;
    const int nblk = N >> 6, kb = item / nblk, nb = item - kb * nblk, k0 = kb * 64, n0 = nb * 64;
    const float* wp = W + (size_t)k0 * N + n0 + lane;
#pragma unroll
    for (int h = 0; h < 2; ++h) {
        float v[32];
#pragma unroll
        for (int i = 0; i < 32; ++i) v[i] = wp[(size_t)(h * 32 + i) * N];
        if (kscale) {
#pragma unroll
            for (int i = 0; i < 32; ++i) v[i] *= kscale[k0 + h * 32 + i]; }
#pragma unroll
        for (int i = 0; i < 32; ++i) scr[(h * 32 + i) * 65 + lane] = v[i];
    }
    LDS_WAIT(); asm volatile("" ::: "memory");
    const int cch = lane & 7, drow0 = conv_row_map(kind, n0);
#pragma unroll
    for (int j = 0; j < 8; ++j) { const int n = (lane >> 3) + 8 * j; const LAS float* s = scr + (8 * cch) * 65 + n;
        u32x4 o; o.x = cvt_pk_bf16(s[0], s[65]); o.y = cvt_pk_bf16(s[2 * 65], s[3 * 65]); o.z = cvt_pk_bf16(s[4 * 65], s[5 * 65]); o.w = cvt_pk_bf16(s[6 * 65], s[7 * 65]);
        *(u32x4*)(WT + (size_t)(drow0 + n) * KP + k0 + 8 * cch) = o; }
    LDS_WAIT(); asm volatile("" ::: "memory");
}
namespace cv { constexpr int I_UP = 32 * 176, I_DN = 88 * 32, I_WIN = 32 * 73, I_UQ = 24 * 24, I_UKV = 8 * 32, I_GLU = 16 * 16, I_G = 32 * 32, I_BR = 16 * 32, I_O = 32 * 32;
    constexpr int CV_A = 2 * I_UP + I_DN, CV_B = CV_A + I_WIN + I_UQ + I_UKV + I_GLU + 3 * I_G, CV_C = CV_B + 3 * I_BR + I_O, CV_N = CV_C + I_DN; }
__device__ __forceinline__ void phase_conv(KArgs a, int l, LAS unsigned char* lds, int G, int lo, int hi, int slo, int shi, int cu0, int tail) {
    using namespace cv;
    int tidx_ = threadIdx.x; asm volatile("" : "+v"(tidx_));
    const int tid = tidx_, lane = tid & 63, wave = tid >> 6, gw = ((int)blockIdx.x - cu0) * 8 + wave, NGW = (G - cu0) * 8;
    LAS float* scr = (LAS float*)(lds + wave * 16640);
    bf16_t* WB = (bf16_t*)(a->ws + WS_WB);
    const float* up = a->in[7] + (size_t)l * 2 * 2048 * 11264; const float* dn = a->in[8] + (size_t)l * 2 * 5632 * 2048;
    const float* win = a->in[9] + (size_t)l * 2048 * 4672; const float* wuq = a->in[12] + (size_t)l * 1536 * 1536; const float* wukv = a->in[13] + (size_t)l * 512 * 2048;
    const float* wglu = a->in[24] + (size_t)l * 1024 * 1024; const float* wg = a->in[26] + (size_t)l * 3 * 2048 * 2048; const float* wbr = a->in[28] + (size_t)l * 3 * 1024 * 2048;
    const float* wo = a->in[29] + (size_t)l * 2048 * 2048;
    for (int it = lo + gw; it < hi; it += NGW) {
        if (it >= slo && it < shi) continue;
        int r = it;
        if (r < I_UP) { conv_item(up, 2048, 11264, WB + WB_UP0, 1, nullptr, scr, r, lane); continue; } r -= I_UP;
        if (r < I_DN) { conv_item(dn, 5632, 2048, WB + WB_DN0, 0, nullptr, scr, r, lane, DFFP); continue; } r -= I_DN;
        if (r < I_UP) { conv_item(up + (size_t)2048 * 11264, 2048, 11264, WB + WB_UP1, 1, nullptr, scr, r, lane); continue; } r -= I_UP;
        if (r < I_WIN) { conv_item(win, 2048, 4672, WB + WB_WIN, 2, nullptr, scr, r, lane); continue; } r -= I_WIN;
        if (r < I_UQ) { conv_item(wuq, 1536, 1536, WB + WB_WUQ, 0, a->in[10] + l * 1536, scr, r, lane); continue; } r -= I_UQ;
        if (r < I_UKV) { conv_item(wukv, 512, 2048, WB + WB_WUKV, 0, a->in[11] + l * 512, scr, r, lane); continue; } r -= I_UKV;
        if (r < I_GLU) { conv_item(wglu, 1024, 1024, WB + WB_WGLU, 0, nullptr, scr, r, lane); continue; } r -= I_GLU;
        if (r < 3 * I_G) { const int n = r / I_G; conv_item(wg + (size_t)n * 2048 * 2048, 2048, 2048, WB + WB_WG + (size_t)n * 2048 * 2048, 0, nullptr, scr, r - n * I_G, lane); continue; } r -= 3 * I_G;
        if (r < 3 * I_BR) { const int n = r / I_BR; conv_item(wbr + (size_t)n * 1024 * 2048, 1024, 2048, WB + WB_WBR + (size_t)n * 2048 * 1024, 0, nullptr, scr, r - n * I_BR, lane); continue; } r -= 3 * I_BR;
        if (r < I_O) { conv_item(wo, 2048, 2048, WB + WB_WO, 0, nullptr, scr, r, lane); continue; } r -= I_O;
        conv_item(dn + (size_t)5632 * 2048, 5632, 2048, WB + WB_DN1, 0, nullptr, scr, r, lane, DFFP);
    }
    if (!tail) return;
    const int ti0 = ((int)blockIdx.x - cu0) * 512 + tid, tst = (G - cu0) * 512;
    { u32x4* z = (u32x4*)(WB + WB_WIN + (size_t)4672 * 2048); const int n16 = 192 * 2048 * 2 / 16;
      unsigned zz = 0u; asm volatile("" : "+v"(zz));
      for (int i = ti0; i < n16; i += tst) z[i] = (u32x4){zz, zz, zz, zz}; }
    {
        f32x2* Pt = (f32x2*)(a->ws + WS_S5P); f32x2* BBt = (f32x2*)(a->ws + WS_S5BB);
        const float* lre = a->in[16] + (size_t)l * 2 * 64 * 64; const float* lim = a->in[17] + (size_t)l * 2 * 64 * 64; const float* ldt = a->in[18] + (size_t)l * 2 * 64;
        const float* bre = a->in[19] + (size_t)l * 2 * 64 * 64 * 16; const float* bim = a->in[20] + (size_t)l * 2 * 64 * 64 * 16;
        for (int i = ti0; i < 8192; i += tst) {
            const int p = i & 63, g = (i >> 6) & 63, d = i >> 12;
            const float lr = fminf(lre[i], -1e-4f), li = lim[i], dt = expf(ldt[d * 64 + g]);
            const size_t o = ((size_t)(g * 2 + d) * 64 + p);
            for (int n = 0; n <= 16; ++n) { const float mg = expf(lr * dt * (float)n), an = li * dt * (float)n; Pt[o * 17 + n] = (f32x2){mg * cosf(an), mg * sinf(an)}; }
            const float th = li * dt, ct = cosf(th), st = sinf(th), sh = sinf(0.5f * th);
            const float nr = expm1f(lr * dt) * ct - 2.f * sh * sh, ni = expf(lr * dt) * st, den = lr * lr + li * li;
            const float f_r = (nr * lr + ni * li) / den, f_i = (ni * lr - nr * li) / den;
            for (int h = 0; h < 16; ++h) { const float br = bre[(size_t)i * 16 + h], bi = bim[(size_t)i * 16 + h]; BBt[o * 16 + h] = (f32x2){f_r * br - f_i * bi, f_r * bi + f_i * br}; }
        }
    }
}
__device__ __forceinline__ void s5_pass2(KArgs a, int l, int G) {
    int tidx_ = threadIdx.x; asm volatile("" : "+v"(tidx_));
    const f32x2* Pt = (const f32x2*)(a->ws + WS_S5P); const f32x2* BBt = (const f32x2*)(a->ws + WS_S5BB); float* KT = (float*)(a->ws + WS_S5K);
    const float* cre = a->in[21] + (size_t)l * 2 * 64 * 16 * 64; const float* cim = a->in[22] + (size_t)l * 2 * 64 * 16 * 64;
    for (int i = blockIdx.x * 512 + tidx_; i < 64 * 2 * 16 * 256; i += G * 512) {
        const int hi_ = i & 15, ho = (i >> 4) & 15, tau = (i >> 8) & 15, d = (i >> 12) & 1, g = i >> 13;
        const size_t o = (size_t)(g * 2 + d) * 64; const float* cr = cre + ((size_t)(d * 64 + g) * 16 + ho) * 64; const float* ci = cim + ((size_t)(d * 64 + g) * 16 + ho) * 64;
        float s = 0.f;
        for (int p = 0; p < 64; ++p) { const f32x2 pw = Pt[(o + p) * 17 + tau], bb = BBt[(o + p) * 16 + hi_];
            const float xr = pw.x * bb.x - pw.y * bb.y, xi = pw.x * bb.y + pw.y * bb.x; s += cr[p] * xr - ci[p] * xi; }
        KT[i] = s;
    }
}
__device__ __forceinline__ void s5_pass3(KArgs a, int l, int G) {
    int tidx_ = threadIdx.x; asm volatile("" : "+v"(tidx_));
    const f32x2* Pt = (const f32x2*)(a->ws + WS_S5P); const f32x2* BBt = (const f32x2*)(a->ws + WS_S5BB); const float* KT = (const float*)(a->ws + WS_S5K);
    const float* cre = a->in[21] + (size_t)l * 2 * 64 * 16 * 64; const float* cim = a->in[22] + (size_t)l * 2 * 64 * 16 * 64; const float* dsk = a->in[23] + (size_t)l * 64 * 16;
    bf16_t* WE = (bf16_t*)(a->ws + WS_WE); bf16_t* WC = (bf16_t*)(a->ws + WS_WC);
    constexpr int NE = 64 * 256 * 32, NC = 64 * 256 * 64;
    for (int i = blockIdx.x * 512 + tidx_; i < NE + NC; i += G * 512) {
        float v[8];
        if (i < NE) {
            const int k8 = i & 31, n = (i >> 5) & 255, g = i >> 13, d = n >> 7, p = (n >> 1) & 63, ri = n & 1, j = k8 >> 1, h0 = (k8 & 1) * 8, e = d == 0 ? 15 - j : j;
            const size_t o = (size_t)(g * 2 + d) * 64 + p; const f32x2 pw = Pt[o * 17 + e];
#pragma unroll
            for (int q = 0; q < 8; ++q) { const f32x2 bb = BBt[o * 16 + h0 + q]; v[q] = ri == 0 ? pw.x * bb.x - pw.y * bb.y : pw.x * bb.y + pw.y * bb.x; }
            u32x4 w; w.x = cvt_pk_bf16(v[0], v[1]); w.y = cvt_pk_bf16(v[2], v[3]); w.z = cvt_pk_bf16(v[4], v[5]); w.w = cvt_pk_bf16(v[6], v[7]);
            *(u32x4*)(WE + (size_t)i * 8) = w;
        } else {
            const int ii = i - NE, k8 = ii & 63, n = (ii >> 6) & 255, g = ii >> 14, ti = n >> 4, ho = n & 15;
            if (k8 < 32) { const int j = k8 >> 1, h0 = (k8 & 1) * 8;
#pragma unroll
                for (int q = 0; q < 8; ++q) { const int hi_ = h0 + q; float s = 0.f;
                    if (j <= ti) s += KT[((size_t)((g * 2 + 0) * 16 + (ti - j)) * 16 + ho) * 16 + hi_];
                    if (j >= ti) s += KT[((size_t)((g * 2 + 1) * 16 + (j - ti)) * 16 + ho) * 16 + hi_];
                    if (j == ti && hi_ == ho) s += dsk[g * 16 + ho];
                    v[q] = s; }
            } else { const int d = (k8 - 32) >> 4, p0 = ((k8 - 32) & 15) * 4, e = d == 0 ? ti + 1 : 16 - ti;
#pragma unroll
                for (int q = 0; q < 4; ++q) { const int p = p0 + q; const f32x2 pw = Pt[((size_t)(g * 2 + d) * 64 + p) * 17 + e];
                    const float cr = cre[((size_t)(d * 64 + g) * 16 + ho) * 64 + p], ci = cim[((size_t)(d * 64 + g) * 16 + ho) * 64 + p];
                    v[2 * q] = cr * pw.x - ci * pw.y; v[2 * q + 1] = -(cr * pw.y + ci * pw.x); }
            }
            u32x4 w; w.x = cvt_pk_bf16(v[0], v[1]); w.y = cvt_pk_bf16(v[2], v[3]); w.z = cvt_pk_bf16(v[4], v[5]); w.w = cvt_pk_bf16(v[6], v[7]);
            *(u32x4*)(WC + (size_t)ii * 8) = w;
        }
    }
}
__device__ __forceinline__ void phase_norm(KArgs a, int l, int gi, int si, int sci, int first, int mode, int cu0, int NGW) {
    int tidx_ = threadIdx.x; asm volatile("" : "+v"(tidx_));
    int bidx_ = blockIdx.x; asm volatile("" : "+s"(bidx_), "+s"(NGW));
    const int lane = tidx_ & 63, gw = (bidx_ - cu0) * 8 + (tidx_ >> 6);
    const f16_t* X = (const f16_t*)(a->ws + WS_X); bf16_t* H = (bf16_t*)(a->ws + WS_H);
    const float* gv = a->in[6] + ((size_t)l * 3 + gi) * DM; const float* modl = (const float*)(a->ws + WS_MOD) + (size_t)l * 9 * 9 * DM;
    const int nwl = mode == 0 ? (NGW * 2) / 17 : (mode == 1 ? NGW / 8 : 0), nwc = mode == 0 ? NGW - 8 * nwl : (mode == 2 ? NGW : 0);
    int mr, wi, nw, nrows;
    if (gw < 8 * nwl) { mr = gw / nwl; wi = gw - mr * nwl; nw = nwl; nrows = SEQ; } else { mr = NB; wi = gw - 8 * nwl; nw = nwc; nrows = NB * CTXL; }
    if (gw < 0 || nw <= 0 || wi >= nw) return;
    const float* mrow = modl + (size_t)mr * 9 * DM;
    f32x4 gm[8], sh[8];
#pragma unroll
    for (int j = 0; j < 8; ++j) { const int c = (lane + 64 * (j >> 1)) * 8 + 4 * (j & 1); gm[j] = *(const f32x4*)(gv + c) * (*(const f32x4*)(mrow + (size_t)sci * DM + c) + 1.0f); sh[j] = *(const f32x4*)(mrow + (size_t)si * DM + c); }
    const float* xin = a->in[0]; const float* cin = a->in[2];
#define NORM_ROW(i, rr, sp) do { if (mr < NB) { rr = (size_t)mr * TOK + CTXL + (i); sp = xin + ((size_t)mr * SEQ + (i)) * DM; } \
        else { const int b_ = (i) >> 8, t_ = (i) & 255; rr = (size_t)b_ * TOK + t_; sp = cin + ((size_t)b_ * CTXL + t_) * DM; } } while (0)
#define NORM_OUT(v) do { float s = 0.f; \
        _Pragma("unroll") for (int j = 0; j < 8; ++j) s += (v[j].x * v[j].x + v[j].y * v[j].y) + (v[j].z * v[j].z + v[j].w * v[j].w); \
        const float rstd = rsqrtf(wave_sum(s) * (1.f / DM) + EPS); \
        _Pragma("unroll") for (int j = 0; j < 4; ++j) { const f32x4 y0 = (v[2 * j] * rstd) * gm[2 * j] + sh[2 * j], y1 = (v[2 * j + 1] * rstd) * gm[2 * j + 1] + sh[2 * j + 1]; \
            u32x4 w; w.x = cvt_pk_bf16(y0.x, y0.y); w.y = cvt_pk_bf16(y0.z, y0.w); w.z = cvt_pk_bf16(y1.x, y1.y); w.w = cvt_pk_bf16(y1.z, y1.w); \
            *(u32x4*)(H + r * DM + (lane + 64 * j) * 8) = w; } } while (0)
    if (first) {
        f32x4 v[8], vn[8]; size_t r = 0, rn = 0; const float* sp = xin; const float* spn = xin;
        int i = wi;
        if (i < nrows) { NORM_ROW(i, r, sp);
#pragma unroll
            for (int j = 0; j < 8; ++j) v[j] = *(const f32x4*)(sp + (lane + 64 * (j >> 1)) * 8 + 4 * (j & 1)); }
        for (; i < nrows; i += nw) {
            const int in_ = i + nw; const bool hn = in_ < nrows;
            if (hn) { NORM_ROW(in_, rn, spn);
#pragma unroll
                for (int j = 0; j < 8; ++j) vn[j] = *(const f32x4*)(spn + (lane + 64 * (j >> 1)) * 8 + 4 * (j & 1)); }
            NORM_OUT(v);
            if (hn) {
#pragma unroll
                for (int j = 0; j < 8; ++j) v[j] = vn[j];
                r = rn; }
        }
    } else {
        u32x4 h[4], hn4[4]; size_t r = 0, rn = 0; const float* spd = xin; (void)spd;
        int i = wi;
        if (i < nrows) { NORM_ROW(i, r, spd);
#pragma unroll
            for (int j = 0; j < 4; ++j) h[j] = *(const u32x4*)(X + r * DM + (lane + 64 * j) * 8); }
        for (; i < nrows; i += nw) {
            const int in_ = i + nw; const bool hn = in_ < nrows;
            if (hn) { NORM_ROW(in_, rn, spd);
#pragma unroll
                for (int j = 0; j < 4; ++j) hn4[j] = *(const u32x4*)(X + rn * DM + (lane + 64 * j) * 8); }
            f32x4 v[8];
#pragma unroll
            for (int j = 0; j < 4; ++j) h8f(h[j], v[2 * j], v[2 * j + 1]);
            NORM_OUT(v);
            if (hn) {
#pragma unroll
                for (int j = 0; j < 4; ++j) h[j] = hn4[j];
                r = rn; }
        }
    }
#undef NORM_OUT
#undef NORM_ROW
}
__device__ __forceinline__ void phase_prep(KArgs a, int l, int G) {
    int tidx_ = threadIdx.x; asm volatile("" : "+v"(tidx_));
    const int lane = tidx_ & 63, gw = blockIdx.x * 8 + (tidx_ >> 6), NGW = G * 8;
    const bf16_t* ZA = (const bf16_t*)(a->ws + WS_AR + AR_ZA); bf16_t* GKV = (bf16_t*)(a->ws + WS_AR + AR_GKV); bf16_t* KR = (bf16_t*)(a->ws + WS_AR + AR_KR);
    float* RS = (float*)(a->ws + WS_RS); const float* RG = (const float*)(a->ws + WS_ROPEG); const float* RM = (const float*)(a->ws + WS_ROPEM);
    const float* gk = a->in[15] + (size_t)l * 128;
    const int hd = lane >> 5, q = lane & 31, ki = lane & 15;
    const float g0 = gk[q], g1 = gk[q + 32], g2 = gk[64 + q], g3 = gk[96 + q];
    for (int r0 = gw; r0 < MR; r0 += 2 * NGW) {
        int rr[2]; bool ok[2], lat[2]; int prow[2], pcol[2];
#pragma unroll
        for (int k = 0; k < 2; ++k) { rr[k] = r0 + k * NGW; ok[k] = rr[k] < MR; if (!ok[k]) rr[k] = r0; const int b = rr[k] / TOK, t = rr[k] - b * TOK; lat[k] = t >= CTXL; const int tt = t - CTXL; prow[k] = tt >> 6; pcol[k] = tt & 63; }
        u32x4 z[2][4]; float x[2][4], y[2][4];
#pragma unroll
        for (int k = 0; k < 2; ++k) { const u32x4* zp = (const u32x4*)(ZA + (size_t)rr[k] * 2048 + lane * 32);
#pragma unroll
            for (int j = 0; j < 4; ++j) z[k][j] = zp[j];
            const bf16_t* kp = GKV + (size_t)rr[k] * 512 + hd * 128; x[k][0] = bf2f(kp[q]); x[k][1] = bf2f(kp[q + 32]); x[k][2] = bf2f(kp[64 + q]); x[k][3] = bf2f(kp[96 + q]);
            const bf16_t* rp = KR + (size_t)rr[k] * 64; y[k][0] = bf2f(rp[ki]); y[k][1] = bf2f(rp[ki + 16]); y[k][2] = bf2f(rp[32 + ki]); y[k][3] = bf2f(rp[48 + ki]); }
#pragma unroll
        for (int k = 0; k < 2; ++k) {
            float s = 0.f;
#pragma unroll
            for (int j = 0; j < 4; ++j) { const u32x4 w = z[k][j]; const float e[8] = {bf_lo(w.x), bf_hi(w.x), bf_lo(w.y), bf_hi(w.y), bf_lo(w.z), bf_hi(w.z), bf_lo(w.w), bf_hi(w.w)};
#pragma unroll
                for (int c = 0; c < 8; ++c) s += e[c] * e[c]; }
            const float sq = wave_sum(lane < 48 ? s : 0.f), sk = wave_sum(lane < 48 ? 0.f : s);
            if (ok[k] && lane == 0) { RS[(size_t)rr[k] * 2] = rsqrtf(sq * (1.f / 1536.f) + EPS); RS[(size_t)rr[k] * 2 + 1] = rsqrtf(sk * (1.f / 512.f) + EPS); }
            float x0 = x[k][0], x1 = x[k][1], x2 = x[k][2], x3 = x[k][3];
            float s2 = x0 * x0 + x1 * x1 + x2 * x2 + x3 * x3;
#pragma unroll
            for (int o = 1; o < 32; o <<= 1) s2 += __shfl_xor(s2, o);
            const float rstd = rsqrtf(s2 * (1.f / 128.f) + EPS);
            x0 *= rstd * g0; x1 *= rstd * g1; x2 *= rstd * g2; x3 *= rstd * g3;
            if (lat[k]) { const float cr = RG[(prow[k] * 32 + q) * 2], sr = RG[(prow[k] * 32 + q) * 2 + 1], cc = RG[(pcol[k] * 32 + q) * 2], sc = RG[(pcol[k] * 32 + q) * 2 + 1];
                const float t0 = x0 * cr - x1 * sr, t1 = x1 * cr + x0 * sr, t2 = x2 * cc - x3 * sc, t3 = x3 * cc + x2 * sc; x0 = t0; x1 = t1; x2 = t2; x3 = t3; }
            if (ok[k]) { bf16_t* kp = GKV + (size_t)rr[k] * 512 + hd * 128; kp[q] = f2bf(x0); kp[q + 32] = f2bf(x1); kp[64 + q] = f2bf(x2); kp[96 + q] = f2bf(x3); }
            if (ok[k] && lat[k] && lane < 16) { bf16_t* rp = KR + (size_t)rr[k] * 64;
                const float cr = RM[(prow[k] * 16 + ki) * 2], sr = RM[(prow[k] * 16 + ki) * 2 + 1], cc = RM[(pcol[k] * 16 + ki) * 2], sc = RM[(pcol[k] * 16 + ki) * 2 + 1];
                rp[ki] = f2bf(y[k][0] * cr - y[k][1] * sr); rp[ki + 16] = f2bf(y[k][1] * cr + y[k][0] * sr); rp[32 + ki] = f2bf(y[k][2] * cc - y[k][3] * sc); rp[48 + ki] = f2bf(y[k][3] * cc + y[k][2] * sc); }
        }
    }
}
__device__ __forceinline__ void phase_scan(KArgs a, int G) {
    int tidx_ = threadIdx.x; asm volatile("" : "+v"(tidx_));
    const int lane = tidx_ & 63, gw = blockIdx.x * 8 + (tidx_ >> 6), NGW = G * 8;
    const f32x2* Pt = (const f32x2*)(a->ws + WS_S5P); const bf16_t* E = (const bf16_t*)(a->ws + WS_AR + AR_E); bf16_t* UGS = (bf16_t*)(a->ws + WS_AR + AR_UGS);
    for (int w = gw; w < NB * 64 * 2; w += NGW) {
        const int d = w & 1, g = (w >> 1) & 63, b = w >> 7;
        const f32x2 a16 = Pt[((size_t)(g * 2 + d) * 64 + lane) * 17 + 16];
        const bf16_t* Eg = E + ((size_t)g * CHRP + b * NCH) * 256 + d * 128 + lane * 2;
        bf16_t* Ug = UGS + ((size_t)g * CHRP + b * NCH) * 512 + 256 + d * 128 + lane * 2;
        float sr = 0.f, si = 0.f;
        unsigned e[8], en[8];
#define SCAN_C(s) (d == 0 ? (s) : ((s) < 16 ? 15 - (s) : 287 - (s)))
#pragma unroll
        for (int q = 0; q < 8; ++q) e[q] = *(const unsigned*)(Eg + (size_t)SCAN_C(q) * 256);
        for (int s0 = 0; s0 < NCH; s0 += 8) {
            if (s0 + 8 < NCH) {
#pragma unroll
                for (int q = 0; q < 8; ++q) en[q] = *(const unsigned*)(Eg + (size_t)SCAN_C(s0 + 8 + q) * 256); }
#pragma unroll
            for (int q = 0; q < 8; ++q) { const int c = SCAN_C(s0 + q);
                *(unsigned*)(Ug + (size_t)c * 512) = cvt_pk_bf16(sr, si);
                const float nr = a16.x * sr - a16.y * si + bf_lo(e[q]), ni = a16.x * si + a16.y * sr + bf_hi(e[q]); sr = nr; si = ni; }
#pragma unroll
            for (int q = 0; q < 8; ++q) e[q] = en[q];
        }
#undef SCAN_C
    }
}
__device__ __forceinline__ void phase_final(KArgs a, int G) {
    int tidx_ = threadIdx.x; asm volatile("" : "+v"(tidx_));
    const int lane = tidx_ & 63, gw = blockIdx.x * 8 + (tidx_ >> 6), NGW = G * 8;
    const f16_t* X = (const f16_t*)(a->ws + WS_X); const float* gv = a->in[30]; float* out = a->out;
    f32x4 g4[8];
#pragma unroll
    for (int j = 0; j < 8; ++j) g4[j] = *(const f32x4*)(gv + (lane + 64 * (j >> 1)) * 8 + 4 * (j & 1));
    u32x4 h[4], hn4[4];
    int r = gw;
    if (r < NB * SEQ) { const f16_t* src = X + ((size_t)(r >> 12) * TOK + CTXL + (r & 4095)) * DM;
#pragma unroll
        for (int j = 0; j < 4; ++j) h[j] = *(const u32x4*)(src + (lane + 64 * j) * 8); }
    for (; r < NB * SEQ; r += NGW) {
        const int rn = r + NGW; const bool hn = rn < NB * SEQ;
        if (hn) { const f16_t* srcn = X + ((size_t)(rn >> 12) * TOK + CTXL + (rn & 4095)) * DM;
#pragma unroll
            for (int j = 0; j < 4; ++j) hn4[j] = *(const u32x4*)(srcn + (lane + 64 * j) * 8); }
        f32x4 v[8];
#pragma unroll
        for (int j = 0; j < 4; ++j) h8f(h[j], v[2 * j], v[2 * j + 1]);
        float s = 0.f;
#pragma unroll
        for (int j = 0; j < 8; ++j) s += (v[j].x * v[j].x + v[j].y * v[j].y) + (v[j].z * v[j].z + v[j].w * v[j].w);
        const float rstd = rsqrtf(wave_sum(s) * (1.f / DM) + EPS);
        float* dst = out + (size_t)r * DM;
#pragma unroll
        for (int j = 0; j < 8; ++j) *(f32x4*)(dst + (lane + 64 * (j >> 1)) * 8 + 4 * (j & 1)) = v[j] * rstd * g4[j];
        if (hn) {
#pragma unroll
            for (int j = 0; j < 4; ++j) h[j] = hn4[j]; }
    }
}

__global__ void __launch_bounds__(512, 2) mk_fwd(Args args_unused) {
    extern __shared__ __attribute__((aligned(16))) unsigned char lds_raw[];
    LAS unsigned char* lds = (LAS unsigned char*)lds_raw;
    volatile LAS unsigned* MISC = (volatile LAS unsigned*)(lds + MISC_OFF);
    const int G = gridDim.x;
    if (threadIdx.x < 64) MISC[threadIdx.x] = 0u;
    __syncthreads();
    XcdBarrier bar; bar.bar = nullptr; bar.x = 0; bar.st = MISC + 8;
    if (!MK_PER_PHASE) { KArgs k0 = kargs(); bar = xcd_barrier_post((unsigned*)(k0->ws + WS_CTL), MISC + 8); }
    int lo, hi; { KArgs k0 = kargs(); lo = k0->ph_lo; hi = k0->ph_hi; }
#define IN(k) (lo <= (k) && (k) < hi)
#define SEAM(k) do { if (IN((k) + 1)) { if (!MK_PER_PHASE) { KArgs kb_ = kargs(); bar.bar = (unsigned*)(kb_->ws + WS_CTL); xcd_barrier(bar); } } } while (0)
#define PH_ENTER() KArgs ka = kargs(); unsigned char* ws = ka->ws; bf16_t* WB = (bf16_t*)(ws + WS_WB); unsigned char* AR = ws + WS_AR; f16_t* X = (f16_t*)(ws + WS_X); const char* Hc = (const char*)(ws + WS_H); \
    const float* modl = (const float*)(ws + WS_MOD) + (size_t)l * 9 * 9 * DM; int cid = (int)blockIdx.x; asm volatile("" : "+s"(cid)); (void)WB; (void)AR; (void)X; (void)Hc; (void)modl; (void)cid

    if (PHON(21) && IN(0)) { KArgs ka = kargs(); phase_pre(ka, lds, G); SEAM(0);
    }

    for (int l = 0; l < DEPTH; ++l) {
        const int pb = 1 + l * NPL; const int lastl = (l == DEPTH - 1);
#define PHASE(k) if (PHON(k) && IN(pb + (k)))
#define GWALL 0, G * 8
        if (l == 0) PHASE(0) { KArgs ka = kargs(); phase_conv(ka, l, lds, G, 0, cv::CV_N, cv::I_UP + cv::I_DN, cv::CV_C, 0, 1); SEAM(pb + 0); }
        PHASE(1) { KArgs ka = kargs(); phase_norm(ka, l, 0, 0, 1, l == 0, 0, GWALL); s5_pass2(ka, l, G); SEAM(pb + 1); }
        PHASE(2) {
            PH_ENTER();
            SchedStd S{Hc, (const char*)(WB + WB_UP0), 4096, 4096, 32, NTM, 44, G, cid, 0, 0}; EpiUp E{(bf16_t*)(AR + AR_HID)};
            pg8::gemm_phase(lds, S, E);
            if (l == 0 && cid >= 96) phase_conv(ka, l, lds, G, cv::I_UP + cv::I_DN, cv::CV_A, 0, 0, 96, 0);
            SEAM(pb + 2); }
        PHASE(3) {
            PH_ENTER();
            SchedStd S{(const char*)(AR + AR_HID), (const char*)(WB + WB_DN0), DFFP * 2, DFFP * 2, 88, 128, 8, G, cid, 1, 1};
            EpiRes E{X, ka->in[0], ka->in[2], modl, 2, 0.5f, l == 0, 0};
            pg8::gemm_phase(lds, S, E); SEAM(pb + 3); }
        PHASE(4) {
            PH_ENTER();
            if (cid < 64) { SchedStd S{(const char*)(AR + AR_HID), (const char*)(WB + WB_DN0), DFFP * 2, DFFP * 2, 88, 8, 8, 64, cid, 2, 0};
                EpiRes E{X, ka->in[0], ka->in[2], modl, 2, 0.5f, l == 0, 0};
                pg8::gemm_phase(lds, S, E); }
            else { phase_norm(ka, l, 1, 3, 4, 0, 1, 64, (G - 64) * 8);
                phase_conv(ka, l, lds, G, l == 0 ? cv::CV_A : cv::CV_C, l == 0 ? cv::CV_B : cv::CV_N, 0, 0, 64, 0); }
            SEAM(pb + 4); }
        PHASE(5) { KArgs ka = kargs(); phase_norm(ka, l, 1, 3, 4, 0, 2, GWALL); s5_pass3(ka, l, G); SEAM(pb + 5); }
        PHASE(6) {
            PH_ENTER();
            SchedStd S{Hc, (const char*)(WB + WB_WIN), 4096, 4096, 32, NTM, 19, G, cid, 0, 0};
            EpiWin E{(bf16_t*)(AR + AR_ZA), (bf16_t*)(AR + AR_UGS), (bf16_t*)(AR + AR_GQ), (bf16_t*)(AR + AR_GKV), (bf16_t*)(AR + AR_KR)};
            pg8::gemm_phase(lds, S, E);
            if (!lastl && cid >= 24) phase_conv(ka, l + 1, lds, G, 0, cv::I_UP, 0, 0, 24, 0);
            SEAM(pb + 6); }
        PHASE(7) { KArgs ka = kargs(); phase_prep(ka, l, G); SEAM(pb + 7); }
        PHASE(8) {
            PH_ENTER();
            SchedMlaUp S{(const char*)(AR + AR_ZA), (const char*)(WB + WB_WUQ), (const char*)(WB + WB_WUKV), NTM, G, cid, 0};
            EpiMlaUp E{(bf16_t*)(AR + AR_Q), (bf16_t*)(AR + AR_KV), (const float*)(ws + WS_RS)};
            pg8::gemm_phase(lds, S, E); SEAM(pb + 8); }
        PHASE(9) {
            PH_ENTER();
            att::AttnP P{(const bf16_t*)(AR + AR_Q), (const bf16_t*)(AR + AR_KV), (const bf16_t*)(AR + AR_KR), (const bf16_t*)(AR + AR_GQ), (const bf16_t*)(AR + AR_GKV),
                         (bf16_t*)(AR + AR_OMLA), (bf16_t*)(AR + AR_OGQA), (const float*)(ws + WS_ROPEG), (const float*)(ws + WS_ROPEM), ka->in[14] + (size_t)l * 128};
            const int nbig = 2 * NB * 8 * 16, nsm = lastl ? 0 : 2 * NB * 8;
            for (int L = cid; L < nbig + nsm; L += G) {
                int kind, b, h, qb;
                if (L < nbig) { const int rnd = L >> 8, c8 = L & 255, vc = (c8 & 7) * 32 + (c8 >> 3), u_ = (rnd >> 1) * 256 + vc;
                    kind = rnd & 1; qb = 1 + (u_ & 15); h = (u_ >> 4) & 7; b = (u_ >> 7) & 7; }
                else { const int q = L - nbig; qb = 0; h = q & 7; b = (q >> 3) & 7; kind = q >> 6; }
                if (kind == 0) att::attn_unit<true>(P, b, h, qb, (char*)lds_raw); else att::attn_unit<false>(P, b, h, qb, (char*)lds_raw);
            }
            __syncthreads();
            { SchedS5 S{(const char*)(AR + AR_UGS), (const char*)(ws + WS_WE), 512, 4, G, cid}; EpiS5A E{(bf16_t*)(AR + AR_E)};
              pg8::gemm_phase(lds, S, E); }
            SEAM(pb + 9); }
        PHASE(11) { KArgs ka = kargs(); phase_scan(ka, G);
            if (l == 0 && (int)blockIdx.x >= 128) phase_conv(ka, l, lds, G, cv::CV_B, cv::CV_C, 0, 0, 128, 0);
            SEAM(pb + 11); }
        PHASE(12) {
            PH_ENTER();
            SchedS5 S{(const char*)(AR + AR_UGS), (const char*)(ws + WS_WC), 1024, 8, G, cid}; EpiS5C E{(bf16_t*)(AR + AR_YS), (bf16_t*)(AR + AR_GEL)};
            pg8::gemm_phase(lds, S, E); SEAM(pb + 12); }
        PHASE(13) {
            PH_ENTER();
            SchedStd S{(const char*)(AR + AR_GEL), (const char*)(WB + WB_WGLU), 2048, 2048, 16, lastl ? 128 : NTM, 4, G, cid, lastl, 0};
            EpiGlu E{(bf16_t*)(AR + AR_BRS5), (const bf16_t*)(AR + AR_YS), ka->in[25] + (size_t)l * 1024};
            pg8::gemm_phase(lds, S, E); SEAM(pb + 13); }
        PHASE(14) {
            PH_ENTER();
            SchedMerge S{(const char*)ws, 128, G, cid, 1};
            EpiMerge E{(bf16_t*)(AR + AR_Y), AR + AR_GS, ka->in[27] + (size_t)l * 3 * DM};
            pg8::gemm_phase(lds, S, E); SEAM(pb + 14); }
        PHASE(15) {
            PH_ENTER();
            if (!lastl && cid < 64) { SchedMerge S{(const char*)ws, 8, 64, cid, 2};
                EpiMerge E{(bf16_t*)(AR + AR_Y), AR + AR_GS, ka->in[27] + (size_t)l * 3 * DM};
                pg8::gemm_phase(lds, S, E);
                SchedStd S2{(const char*)(AR + AR_Y), (const char*)(WB + WB_WO), 4096, 4096, 32, 128, 8, 64, cid, 1, 0, 960, 1024};
                EpiRes E2{X, ka->in[0], ka->in[2], modl, 5, 1.0f, 0, 0};
                pg8::gemm_phase(lds, S2, E2); }
            else { SchedStd S{(const char*)(AR + AR_Y), (const char*)(WB + WB_WO), 4096, 4096, 32, 128, 8, lastl ? G : G - 64, lastl ? cid : cid - 64, 1, 0, 0, lastl ? 1024 : 960};
                EpiRes E{X, ka->in[0], ka->in[2], modl, 5, 1.0f, 0, 0};
                pg8::gemm_phase(lds, S, E); }
            SEAM(pb + 15); }
        PHASE(16) {
            PH_ENTER();
            if (!lastl && cid < 64) { SchedStd S{(const char*)(AR + AR_Y), (const char*)(WB + WB_WO), 4096, 4096, 32, 8, 8, 64, cid, 2, 0};
                EpiRes E{X, ka->in[0], ka->in[2], modl, 5, 1.0f, 0, 0};
                pg8::gemm_phase(lds, S, E); }
            else if (!lastl) phase_norm(ka, l, 2, 6, 7, 0, 1, 64, (G - 64) * 8);
            else phase_norm(ka, l, 2, 6, 7, 0, 1, GWALL);
            SEAM(pb + 16); }
        if (!lastl) PHASE(17) { KArgs ka = kargs(); phase_norm(ka, l, 2, 6, 7, 0, 2, GWALL); SEAM(pb + 17); }
        PHASE(18) {
            PH_ENTER();
            SchedStd S{Hc, (const char*)(WB + WB_UP1), 4096, 4096, 32, lastl ? 128 : NTM, 44, G, cid, lastl, 0}; EpiUp E{(bf16_t*)(AR + AR_HID)};
            pg8::gemm_phase(lds, S, E);
            if (!lastl && cid >= 96) phase_conv(ka, l + 1, lds, G, cv::I_UP, cv::I_UP + cv::I_DN, 0, 0, 96, 0);
            SEAM(pb + 18); }
        PHASE(19) {
            PH_ENTER();
            SchedStd S{(const char*)(AR + AR_HID), (const char*)(WB + WB_DN1), DFFP * 2, DFFP * 2, 88, 128, 8, G, cid, 1, 1};
            EpiRes E{X, ka->in[0], ka->in[2], modl, 8, 0.5f, 0, 0};
            pg8::gemm_phase(lds, S, E); SEAM(pb + 19); }
        if (!lastl) PHASE(20) {
            PH_ENTER();
            if (cid < 64) { SchedStd S{(const char*)(AR + AR_HID), (const char*)(WB + WB_DN1), DFFP * 2, DFFP * 2, 88, 8, 8, 64, cid, 2, 0};
                EpiRes E{X, ka->in[0], ka->in[2], modl, 8, 0.5f, 0, 0};
                pg8::gemm_phase(lds, S, E); }
            else phase_conv(ka, l + 1, lds, G, cv::I_UP + cv::I_DN, cv::CV_C, 0, 0, 64, 1);
            SEAM(pb + 20); }
#undef PHASE
#undef GWALL
    }
    if (PHON(22) && IN(PH_FINAL)) { KArgs ka = kargs(); phase_final(ka, G); }
#undef IN
#undef SEAM
#undef PH_ENTER
}

extern "C" void kernel_launch(void* const* d_in, const int* in_sizes, int n_in, void* d_out, int out_size, void* d_ws, size_t ws_size, hipStream_t stream) {
    static int grid = 0;
    if (grid == 0) {
        if (n_in != 31 || out_size != NB * SEQ * DM || ws_size < WS_END) { fprintf(stderr, "kernel_launch: unexpected shapes (n_in %d out %d ws %zu, need %zu)\n", n_in, out_size, ws_size, (size_t)WS_END); grid = -1; return; }
        int dev = 0, cus = 0, per_cu = 0;
        if (hipGetDevice(&dev) != hipSuccess || hipDeviceGetAttribute(&cus, hipDeviceAttributeMultiprocessorCount, dev) != hipSuccess) { grid = -1; return; }
        if (hipFuncSetAttribute((const void*)mk_fwd, hipFuncAttributeMaxDynamicSharedMemorySize, LDS_BYTES) != hipSuccess) { fprintf(stderr, "kernel_launch: hipFuncSetAttribute failed\n"); grid = -1; return; }
        if (hipOccupancyMaxActiveBlocksPerMultiprocessor(&per_cu, (const void*)mk_fwd, 512, LDS_BYTES) != hipSuccess || per_cu < 1) fprintf(stderr, "kernel_launch: occupancy query says %d\n", per_cu);
        (void)hipGetLastError();
        grid = cus;
    }
    if (grid < 0) return;
    if (hipMemsetAsync((char*)d_ws + WS_CTL, 0, CTL_ZERO_BYTES, stream) != hipSuccess) return;
    Args a{};
    for (int i = 0; i < 31; ++i) a.in[i] = (const float*)d_in[i];
    a.out = (float*)d_out; a.ws = (unsigned char*)d_ws;
#if MK_PER_PHASE
    for (int p = 0; p < NPH; ++p) { a.ph_lo = p; a.ph_hi = p + 1; hipLaunchKernelGGL(mk_fwd, dim3(grid), dim3(512), LDS_BYTES, stream, a); }
#else
    a.ph_lo = 0; a.ph_hi = NPH;
    hipLaunchKernelGGL(mk_fwd, dim3(grid), dim3(512), LDS_BYTES, stream, a);
#endif
    const hipError_t le = hipPeekAtLastError();
    if (le != hipSuccess) fprintf(stderr, "kernel_launch: launch failed: %s\n", hipGetErrorName(le));
}
```

```cpp
#include <hip/hip_runtime.h>
#include <cstdio>
#include <cstdint>

#ifndef MK_PER_PHASE
#define MK_PER_PHASE 0
#endif

#ifndef PHMASK
#define PHMASK 0x7FFFFFu
#endif
#define PHON(k) (((PHMASK) >> (k)) & 1u)
#define GAS __attribute__((address_space(1)))
#define LAS __attribute__((address_space(3)))
typedef unsigned short bf16_t;
typedef short bf16x8 __attribute__((ext_vector_type(8)));
typedef short s16x4 __attribute__((ext_vector_type(4)));
typedef float f32x2 __attribute__((ext_vector_type(2)));
typedef float f32x4 __attribute__((ext_vector_type(4)));
typedef float f32x8 __attribute__((ext_vector_type(8)));
typedef float f32x16 __attribute__((ext_vector_type(16)));
typedef unsigned u32x2 __attribute__((ext_vector_type(2)));
typedef unsigned u32x4 __attribute__((ext_vector_type(4)));

constexpr int DM = 2048, NB = 8, SEQ = 4096, CTXL = 256, TOK = SEQ + CTXL, MR = NB * TOK, NTM = MR / 256, TPB = TOK / 256;
constexpr int DEPTH = 2, NMODV = 9, DFF = 5632, DINP = 4864;
constexpr int DFFP = 5696;
constexpr int NCH = TOK / 16, CHR = NB * NCH, CHRP = 2304;
constexpr float EPS = 1e-6f;

constexpr size_t MiB = (size_t)1 << 20;
constexpr size_t WS_CTL = 0, CTL_ZERO_BYTES = 65536;
constexpr size_t WS_MOD = 1 * MiB;
constexpr size_t WS_ROPEG = 3 * MiB, WS_ROPEM = 3 * MiB + 16384, WS_RS = 3 * MiB + 65536;
constexpr size_t WS_S5P = 4 * MiB, WS_S5BB = 6 * MiB, WS_S5K = 7 * MiB, WS_WE = 9 * MiB, WS_WC = 17 * MiB;
constexpr size_t WS_WB = 33 * MiB, WS_X = 237 * MiB, WS_H = 509 * MiB, WS_AR = 645 * MiB, WS_END = 1338 * MiB;
constexpr size_t WB_UP0 = 0, WB_UP1 = WB_UP0 + (size_t)11264 * 2048, WB_DN0 = WB_UP1 + (size_t)11264 * 2048, WB_DN1 = WB_DN0 + (size_t)2048 * DFFP,
                 WB_WIN = WB_DN1 + (size_t)2048 * DFFP, WB_WUQ = WB_WIN + (size_t)DINP * 2048, WB_WUKV = WB_WUQ + (size_t)1536 * 1536, WB_WGLU = WB_WUKV + (size_t)2048 * 512,
                 WB_WG = WB_WGLU + (size_t)1024 * 1024, WB_WBR = WB_WG + (size_t)3 * 2048 * 2048, WB_WO = WB_WBR + (size_t)3 * 2048 * 1024, WB_TOTAL = WB_WO + (size_t)2048 * 2048;
static_assert(WS_WB + WB_TOTAL * 2 <= WS_X, "weights fit");
constexpr size_t AR_HID = 0, AR_ZA = 0, AR_OMLA = 0, AR_OGQA = 68 * MiB, AR_Q = 136 * MiB, AR_KV = 238 * MiB, AR_E = 136 * MiB, AR_YS = 280 * MiB, AR_Y = 136 * MiB,
                 AR_UGS = 374 * MiB, AR_GQ = 518 * MiB, AR_BRS5 = 518 * MiB, AR_GKV = 586 * MiB, AR_GS = 586 * MiB, AR_KR = 620 * MiB, AR_GEL = 625 * MiB, AR_END = 693 * MiB;
static_assert(WS_AR + AR_END <= WS_END, "arena fits");

constexpr int LDS_BYTES = 147456, MISC_OFF = LDS_BYTES - 256;

constexpr int NPL = 21, PH_FINAL = 1 + DEPTH * NPL, NPH = PH_FINAL + 1;

#define LDS_WAIT() asm volatile("s_waitcnt lgkmcnt(0)" ::: "memory")
#define VM_WAIT() asm volatile("s_waitcnt vmcnt(0)" ::: "memory")

typedef __bf16 bf16x2_t __attribute__((ext_vector_type(2)));
__device__ __forceinline__ unsigned cvt_pk_bf16(float lo, float hi) { f32x2 v = {lo, hi}; bf16x2_t b = __builtin_convertvector(v, bf16x2_t); return __builtin_bit_cast(unsigned, b); }
typedef _Float16 f16_t;
typedef _Float16 f16x2_t __attribute__((ext_vector_type(2)));
__device__ __forceinline__ unsigned cvt_pk_f16(float lo, float hi) { f32x2 v = {lo, hi}; f16x2_t h = __builtin_convertvector(v, f16x2_t); return __builtin_bit_cast(unsigned, h); }
__device__ __forceinline__ f32x2 h2f2(unsigned w) { return __builtin_convertvector(__builtin_bit_cast(f16x2_t, w), f32x2); }
__device__ __forceinline__ void h8f(const u32x4 h, f32x4& a, f32x4& b) { const f32x2 p = h2f2(h.x), q = h2f2(h.y), r = h2f2(h.z), t = h2f2(h.w); a = (f32x4){p.x, p.y, q.x, q.y}; b = (f32x4){r.x, r.y, t.x, t.y}; }
__device__ __forceinline__ u32x4 f8h(const f32x4 a, const f32x4 b) { u32x4 w; w.x = cvt_pk_f16(a.x, a.y); w.y = cvt_pk_f16(a.z, a.w); w.z = cvt_pk_f16(b.x, b.y); w.w = cvt_pk_f16(b.z, b.w); return w; }
__device__ __forceinline__ float bf_lo(unsigned w) { return __uint_as_float(w << 16); }
__device__ __forceinline__ float bf_hi(unsigned w) { return __uint_as_float(w & 0xffff0000u); }
__device__ __forceinline__ float bf2f(bf16_t b) { return __uint_as_float(((unsigned)b) << 16); }
__device__ __forceinline__ bf16_t f2bf(float f) { return (bf16_t)(cvt_pk_bf16(f, 0.f) & 0xffffu); }
__device__ __forceinline__ float sigmoidf_(float x) { return __builtin_amdgcn_rcpf(1.0f + __builtin_amdgcn_exp2f(-1.4426950408889634f * x)); }
__device__ __forceinline__ float siluf_(float x) { return x * sigmoidf_(x); }
__device__ __forceinline__ float gelu_tanh_(float x) { const float z = 0.7978845608028654f * (x + 0.044715f * x * x * x); return x * sigmoidf_(2.0f * z); }
__device__ __forceinline__ float wave_sum(float v) {
#pragma unroll
    for (int o = 1; o < 64; o <<= 1) v += __shfl_xor(v, o);
    return v;
}

#define XB_TMO      128
#define XB_XCNT(j)  (256  + 64 * (j))
#define XB_XSUB(j)  (1280 + 64 * (j))
#define XB_XGEN(j)  (2304 + 64 * (j))
#define XB_TOP      3328
#define XB_TOPGEN   3392
#define XCD_BAR_WORDS 3456
#define XB_SPIN_CAP (1u << 22)
__device__ __forceinline__ unsigned xb_ld(unsigned* p)              { return __hip_atomic_load(p, __ATOMIC_RELAXED, __HIP_MEMORY_SCOPE_AGENT); }
__device__ __forceinline__ unsigned xb_add(unsigned* p, unsigned v) { return __hip_atomic_fetch_add(p, v, __ATOMIC_RELAXED, __HIP_MEMORY_SCOPE_AGENT); }
__device__ __forceinline__ unsigned xb_xcc_id() { return (unsigned)__builtin_amdgcn_s_getreg((3 << 11) | 20) & 0xFu; }
#define XB_SPIN(cond, bar) do { unsigned _sp = 0; while (cond) { __builtin_amdgcn_s_sleep(1); \
    if ((++_sp & 255u) == 0u) { if (xb_ld(&(bar)[XB_TMO])) break; if (_sp > XB_SPIN_CAP) { atomicAdd(&(bar)[XB_TMO], 1u); break; } } } } while (0)
struct XcdBarrier { unsigned* bar; unsigned x; volatile LAS unsigned* st; };
__device__ __forceinline__ XcdBarrier xcd_barrier_post(unsigned* bar, volatile LAS unsigned* st) {
    XcdBarrier b; b.bar = bar; b.x = xb_xcc_id(); b.st = st;
    if (threadIdx.x == 0) (void)xb_add(&bar[XB_XCNT(b.x)], 1u);
    return b;
}
__device__ __forceinline__ void xcd_barrier_complete(unsigned* bar, unsigned x, unsigned& nloc, unsigned& nx) {
    const unsigned G = gridDim.x * gridDim.y * gridDim.z;
    unsigned sum, cnt, mine, sp = 0u;
    for (;;) {
        sum = 0u; cnt = 0u;
        for (unsigned j = 0; j < 16; ++j) { const unsigned c = xb_ld(&bar[XB_XCNT(j)]); sum += c; cnt += (c > 0u) ? 1u : 0u; }
        if (sum == G) break;
        __builtin_amdgcn_s_sleep(1);
        if ((++sp & 255u) == 0u) { if (xb_ld(&bar[XB_TMO])) break; if (sp > XB_SPIN_CAP) { atomicAdd(&bar[XB_TMO], 1u); break; } }
    }
    mine = xb_ld(&bar[XB_XCNT(x)]);
    nloc = mine > 0u ? mine : 1u; nx = cnt > 0u ? cnt : 1u;
}
__device__ __forceinline__ void xcd_barrier(const XcdBarrier& b) {
    asm volatile("s_waitcnt vmcnt(0)" ::: "memory");
    __syncthreads();
    if (threadIdx.x == 0) {
        unsigned* bar = b.bar; asm volatile("" : "+s"(bar));
        __builtin_amdgcn_s_waitcnt(0);
        unsigned nloc = b.st[0], nx = b.st[1];
        if (nloc == 0u) { xcd_barrier_complete(bar, b.x, nloc, nx); b.st[0] = nloc; b.st[1] = nx; }
        const unsigned old = xb_add(&bar[XB_XSUB(b.x)], 1u);
        const unsigned gen = old / nloc;
        if (old + 1u == (gen + 1u) * nloc) {
            __builtin_amdgcn_fence(__ATOMIC_RELEASE, "agent");
            asm volatile("s_waitcnt vmcnt(0)" ::: "memory");
            const unsigned og = xb_add(&bar[XB_TOP], 1u);
            const unsigned tg = og / nx;
            if (og + 1u == (tg + 1u) * nx) xb_add(&bar[XB_TOPGEN], 1u);
            else XB_SPIN(xb_ld(&bar[XB_TOPGEN]) == tg, bar);
            __builtin_amdgcn_fence(__ATOMIC_ACQUIRE, "agent");
            xb_add(&bar[XB_XGEN(b.x)], 1u);
            asm volatile("s_waitcnt vmcnt(0)" ::: "memory");
        } else {
            XB_SPIN(xb_ld(&bar[XB_XGEN(b.x)]) == gen, bar);
            __builtin_amdgcn_fence(__ATOMIC_ACQUIRE, "agent");
            asm volatile("s_waitcnt vmcnt(0)" ::: "memory");
        }
    }
    __syncthreads();
}

namespace pg8 {
constexpr int BM = 256, BK = 64, HALF = 128, HTB = HALF * BK * 2, STAGE_BYTES = 8 * HTB, NXCD = 8, WGM = 4;
__host__ __device__ __forceinline__ int lds_byte(int r, int c) { const int st = (r >> 4) * 2 + (c >> 5), rr = r & 15, cc = c & 31, ob = rr * 64 + cc * 2; return st * 1024 + (ob ^ (((ob >> 9) & 1) << 5)); }
__host__ __device__ __forceinline__ void stage_rc(int b, int& R, int& C) { const int st = b / 1024, sb = b % 1024, swz = sb ^ (((sb >> 9) & 1) << 5); R = (st >> 1) * 16 + swz / 64; C = (st & 1) * 32 + (swz % 64) / 2; }
__host__ __device__ __forceinline__ int perm32(int rho) { const int n = rho >> 4, i = rho & 15; return 8 * (i >> 2) + 4 * n + (i & 3); }

struct UnitD { const char* A; const char* B; unsigned lda, ldb; int nt, pm, pn, tag; };

__device__ __forceinline__ void static_tile(int L, int nM, int nN, int& pm, int& pn, int rev = 0) {
    const int nwg = nM * nN; int wgid = L;
    { const int q = nwg / NXCD, r = nwg % NXCD, xcd = wgid % NXCD, len = xcd < r ? q + 1 : q; int off = wgid / NXCD; if (rev) off = len - 1 - off; wgid = (xcd < r ? xcd * (q + 1) : r * (q + 1) + (xcd - r) * q) + off; }
    const int nig = WGM * nN, gid = wgid / nig, fm = gid * WGM, gsz = (nM - fm) < WGM ? (nM - fm) : WGM;
    pm = fm + ((wgid % nig) % gsz); pn = (wgid % nig) / gsz;
}

template <class Epi, class Sched>
__device__ __forceinline__ void gemm_phase(LAS unsigned char* lds, const Sched& S, const Epi& E) {
    int tid = threadIdx.x; asm volatile("" : "+v"(tid));
    const int wid = __builtin_amdgcn_readfirstlane(tid >> 6), lane = tid & 63, wr = wid >> 2, wc = wid & 3, fr = lane & 15, fq = lane >> 4;
    int R0, C0, R1, C1; stage_rc(tid * 16, R0, C0); stage_rc(tid * 16 + 8192, R1, C1);
    const int Rb0 = Epi::PERM ? ((R0 & ~31) + perm32(R0 & 31)) : R0, Rb1 = Epi::PERM ? ((R1 & ~31) + perm32(R1 & 31)) : R1;
    const unsigned ldsw = (unsigned)wid * 1024u;
    const int aoff = lds_byte(wr * 64 + fr, fq * 8), boff = lds_byte(wc * 32 + fr, fq * 8);
#define PG8_SA(b, h) (((b) * 2 + (h)) * HTB)
#define PG8_SB(b, h) ((4 + (b) * 2 + (h)) * HTB)
#define PG8_STAGE(bufoff, gbase, v0, v1) do { \
        __builtin_amdgcn_global_load_lds((const unsigned*)((const char*)(gbase) + (v0)), (LAS unsigned*)(lds + (bufoff) + ldsw), 16, 0, 0); \
        __builtin_amdgcn_global_load_lds((const unsigned*)((const char*)(gbase) + (v1)), (LAS unsigned*)(lds + (bufoff) + ldsw + 8192), 16, 0, 0); } while (0)
#define PG8_LDA(dst, b, h) do { _Pragma("unroll") for (int m = 0; m < 4; ++m) _Pragma("unroll") for (int k = 0; k < 2; ++k) dst[m][k] = *(const LAS bf16x8*)(lds + PG8_SA(b, h) + aoff + m * 2048 + k * 1024); } while (0)
#define PG8_LDB(dst, b, h) do { _Pragma("unroll") for (int n = 0; n < 2; ++n) _Pragma("unroll") for (int k = 0; k < 2; ++k) dst[n][k] = *(const LAS bf16x8*)(lds + PG8_SB(b, h) + boff + n * 2048 + k * 1024); } while (0)
#define PG8_MMA(ai, bj, At, Bt) do { __builtin_amdgcn_s_setprio(1); _Pragma("unroll") for (int m = 0; m < 4; ++m) _Pragma("unroll") for (int n = 0; n < 2; ++n) _Pragma("unroll") for (int k = 0; k < 2; ++k) \
        acc[ai][bj][m][n] = __builtin_amdgcn_mfma_f32_16x16x32_bf16(Bt[n][k], At[m][k], acc[ai][bj][m][n], 0, 0, 0); __builtin_amdgcn_s_setprio(0); } while (0)
#define PG8_WAIT_V(n) asm volatile("s_waitcnt vmcnt(" #n ")" ::: "memory")
#define PG8_WAIT_L(n) asm volatile("s_waitcnt lgkmcnt(" #n ")" ::: "memory")
#define PG8_BAR __builtin_amdgcn_s_barrier()
#define PG8_SCHED __builtin_amdgcn_sched_barrier(0)
    UnitD cur, nxt; int ui = 0;
    if (!S.get(0, cur)) return;
    f32x4 acc[2][2][4][2];
#pragma unroll
    for (int a = 0; a < 2; ++a)
#pragma unroll
        for (int b = 0; b < 2; ++b)
#pragma unroll
            for (int m = 0; m < 4; ++m)
#pragma unroll
                for (int n = 0; n < 2; ++n) acc[a][b][m][n] = (f32x4){0.f, 0.f, 0.f, 0.f};
    bf16x8 At[4][2], B0[2][2], B1[2][2];
    const size_t kstep = (size_t)(BK * 2);
    unsigned cvA0 = (unsigned)R0 * cur.lda + (unsigned)C0 * 2u, cvA1 = (unsigned)R1 * cur.lda + (unsigned)C1 * 2u;
    unsigned cvB0 = (unsigned)Rb0 * cur.ldb + (unsigned)C0 * 2u, cvB1 = (unsigned)Rb1 * cur.ldb + (unsigned)C1 * 2u;
    {
        const char* cA = cur.A; const char* cB = cur.B; const size_t hA = (size_t)HALF * cur.lda, hB = (size_t)HALF * cur.ldb;
        PG8_STAGE(PG8_SB(0, 0), cB, cvB0, cvB1); PG8_STAGE(PG8_SB(0, 1), cB + hB, cvB0, cvB1); PG8_STAGE(PG8_SA(0, 0), cA, cvA0, cvA1); PG8_STAGE(PG8_SA(0, 1), cA + hA, cvA0, cvA1);
        if (wr == 1) PG8_BAR;
        PG8_WAIT_V(2); PG8_BAR;
        PG8_STAGE(PG8_SB(1, 0), cB + kstep, cvB0, cvB1); PG8_STAGE(PG8_SA(1, 0), cA + kstep, cvA0, cvA1); PG8_STAGE(PG8_SB(1, 1), cB + hB + kstep, cvB0, cvB1);
        PG8_WAIT_V(6); PG8_BAR;
    }
    for (;;) {
        const bool has_next = S.get(ui + 1, nxt);
        if (!has_next) nxt = cur;
        const unsigned nvA0 = (unsigned)R0 * nxt.lda + (unsigned)C0 * 2u, nvA1 = (unsigned)R1 * nxt.lda + (unsigned)C1 * 2u;
        const unsigned nvB0 = (unsigned)Rb0 * nxt.ldb + (unsigned)C0 * 2u, nvB1 = (unsigned)Rb1 * nxt.ldb + (unsigned)C1 * 2u;
        const char* cA = cur.A; const char* cB = cur.B; const size_t hAc = (size_t)HALF * cur.lda;
        const int nt = cur.nt;
        for (int t = 0; t < nt; t += 2) {
            const bool last = (t == nt - 2);
            const char* a1 = cA + (size_t)(t + 1) * kstep;
            const char* a2 = last ? nxt.A : cA + (size_t)(t + 2) * kstep; const char* b2 = last ? nxt.B : cB + (size_t)(t + 2) * kstep;
            const char* a3 = a2 + kstep; const char* b3 = b2 + kstep;
            const unsigned vA0 = last ? nvA0 : cvA0, vA1 = last ? nvA1 : cvA1, vB0 = last ? nvB0 : cvB0, vB1 = last ? nvB1 : cvB1;
            const size_t hA2 = (size_t)HALF * (last ? nxt.lda : cur.lda), hB2 = (size_t)HALF * (last ? nxt.ldb : cur.ldb);
            PG8_LDB(B0, 0, 0); PG8_LDB(B1, 0, 1); PG8_SCHED; PG8_LDA(At, 0, 0); PG8_STAGE(PG8_SA(1, 1), a1 + hAc, cvA0, cvA1);
            PG8_WAIT_V(8); PG8_WAIT_L(0); PG8_BAR; PG8_MMA(0, 0, At, B0); PG8_MMA(0, 1, At, B1); PG8_BAR; PG8_SCHED;
            PG8_LDA(At, 0, 1); PG8_STAGE(PG8_SB(0, 0), b2, vB0, vB1); PG8_STAGE(PG8_SB(0, 1), b2 + hB2, vB0, vB1); PG8_STAGE(PG8_SA(0, 0), a2, vA0, vA1);
            PG8_WAIT_V(8); PG8_WAIT_L(0); PG8_BAR; PG8_MMA(1, 0, At, B0); PG8_MMA(1, 1, At, B1); PG8_BAR; PG8_SCHED;
            PG8_LDB(B0, 1, 0); PG8_LDB(B1, 1, 1); PG8_SCHED; PG8_LDA(At, 1, 0); PG8_STAGE(PG8_SA(0, 1), a2 + hA2, vA0, vA1);
            PG8_WAIT_V(8); PG8_WAIT_L(0); PG8_BAR; PG8_MMA(0, 0, At, B0); PG8_MMA(0, 1, At, B1); PG8_BAR; PG8_SCHED;
            PG8_LDA(At, 1, 1); PG8_STAGE(PG8_SB(1, 0), b3, vB0, vB1); PG8_STAGE(PG8_SB(1, 1), b3 + hB2, vB0, vB1); PG8_STAGE(PG8_SA(1, 0), a3, vA0, vA1);
            PG8_WAIT_V(8); PG8_WAIT_L(0); PG8_BAR; PG8_MMA(1, 0, At, B0); PG8_MMA(1, 1, At, B1); PG8_BAR; PG8_SCHED;
        }
        if (wr == 0) PG8_BAR;
        { int fr2 = fr, fq2 = fq; asm volatile("" : "+v"(fr2), "+v"(fq2));
          E(acc, cur, wr, wc, fr2, fq2);
        }
        if (!has_next) break;
#pragma unroll
        for (int a = 0; a < 2; ++a)
#pragma unroll
            for (int b = 0; b < 2; ++b)
#pragma unroll
                for (int m = 0; m < 4; ++m)
#pragma unroll
                    for (int n = 0; n < 2; ++n) acc[a][b][m][n] = (f32x4){0.f, 0.f, 0.f, 0.f};
        cur = nxt; cvA0 = nvA0; cvA1 = nvA1; cvB0 = nvB0; cvB1 = nvB1; ++ui;
        if (wr == 1) PG8_BAR;
    }
    PG8_WAIT_V(0);
    PG8_BAR;
#undef PG8_SA
#undef PG8_SB
#undef PG8_STAGE
#undef PG8_LDA
#undef PG8_LDB
#undef PG8_MMA
#undef PG8_WAIT_V
#undef PG8_WAIT_L
#undef PG8_BAR
#undef PG8_SCHED
}
}
using pg8::UnitD;

__device__ __forceinline__ int lat_tile(int i) { return (i >> 4) * TPB + 1 + (i & 15); }
__device__ __forceinline__ int tile_mrow(int pm) { return (pm % TPB == 0) ? NB : pm / TPB; }

struct SchedStd {
    const char* A; const char* B; unsigned lda, ldb; int nt, nM, nN, G, c, lat, rev; int off = 0, lim = 1 << 30;
    __device__ __forceinline__ bool get(int i, UnitD& u) const {
        const long L = (long)i * G + c + off;
        int pm, pn;
        if (lat == 3) {
            const int nl = 128 * nN;
            if (L < nl) { pg8::static_tile((int)L, 128, nN, pm, pn, rev); pm = lat_tile(pm); }
            else { const int q = (int)L - nl; if (q >= NB * 9) return false; const int b = q / 9, j = q - b * 9; pm = b * TPB; pn = j < 6 ? 6 + j : 10 + j; }
        } else {
            if (L >= (long)nM * nN || L >= (long)lim) return false;
            pg8::static_tile((int)L, nM, nN, pm, pn, rev); if (lat == 1) pm = lat_tile(pm); else if (lat == 2) pm = pm * TPB; }
        u.A = A + (size_t)pm * 256 * lda; u.B = B + (size_t)pn * 256 * ldb; u.lda = lda; u.ldb = ldb; u.nt = nt; u.pm = pm; u.pn = pn; u.tag = 0; return true;
    }
};
struct SchedMlaUp {
    const char* ZA; const char* Wuq; const char* Wukv; int nM, G, c, lat;
    __device__ __forceinline__ bool get(int i, UnitD& u) const {
        const int n0 = nM * 6, n1 = nM * 8; int L;
        const int nq = (n0 - c + G - 1) / G;
        if (i < nq) L = i * G + c;
        else { const int j = i - nq, q4 = n0 - (n0 / G) * G;
            if (G == 256 && nM == NTM) { if (c < q4) { if (j >= 1) return false; L = n0 + c; } else { if (j >= 5) return false; L = n0 + q4 + (c - q4) * 5 + j; } if (L >= n0 + n1) return false; }
            else { L = n0 + j * G + c; if (L >= n0 + n1) return false; } }
        int pm, pn;
        if (L < n0) { pg8::static_tile(L, nM, 6, pm, pn); if (lat) pm = lat_tile(pm); u.A = ZA + (size_t)pm * 256 * 4096; u.B = Wuq + (size_t)pn * 256 * 3072; u.ldb = 3072; u.nt = 24; u.tag = 0; }
        else { pg8::static_tile(L - n0, nM, 8, pm, pn); if (lat) pm = lat_tile(pm); u.A = ZA + (size_t)pm * 256 * 4096 + 1536 * 2; u.B = Wukv + (size_t)pn * 256 * 1024; u.ldb = 1024; u.nt = 8; u.tag = 1; }
        u.lda = 4096; u.pm = pm; u.pn = pn; return true;
    }
};
struct SchedMerge {
    const char* ws; int nM, G, c, lat;
    __device__ __forceinline__ bool get(int i, UnitD& u) const {
        const int su = i / 6, tag = i - su * 6, L = su * G + c; if (L >= nM * 8) return false;
        int pm, pn; pg8::static_tile(L, nM, 8, pm, pn); if (lat == 1) pm = lat_tile(pm); else if (lat == 2) pm = pm * TPB;
        const int n = tag >> 1;
        if (tag & 1) { const size_t bro = WS_AR + (n == 0 ? AR_OMLA : (n == 1 ? AR_BRS5 : AR_OGQA));
            u.A = ws + bro + (size_t)pm * 256 * 2048; u.lda = 2048; u.B = ws + WS_WB + WB_WBR * 2 + ((size_t)n * 2048 + pn * 256) * 2048; u.ldb = 2048; u.nt = 16; }
        else { u.A = ws + WS_H + (size_t)pm * 256 * 4096; u.lda = 4096; u.B = ws + WS_WB + WB_WG * 2 + ((size_t)n * 2048 + pn * 256) * 4096; u.ldb = 4096; u.nt = 32; }
        u.pm = pm; u.pn = pn; u.tag = tag; return true;
    }
};
struct SchedS5 {
    const char* UgS; const char* W; unsigned ldb; int nt, G, c;
    __device__ __forceinline__ bool get(int i, UnitD& u) const {
        const int L = i * G + c; if (L >= 64 * 9) return false;
        const int g = L / 9, mt = L - g * 9;
        u.A = UgS + ((size_t)g * CHRP + mt * 256) * 1024; u.lda = 1024; u.B = W + (size_t)g * 256 * ldb; u.ldb = ldb; u.nt = nt; u.pm = g; u.pn = mt; u.tag = 0; return true;
    }
};

#define ACC_T const f32x4 (&acc)[2][2][4][2]
struct EpiUp {
    static constexpr bool PERM = true; static constexpr int KIND = 1; bf16_t* HID;
    __device__ __forceinline__ void operator()(ACC_T, const UnitD& u, int wr, int wc, int fr, int fq) const {
        const int row0 = u.pm * 256 + wr * 64 + fr, col0 = u.pn * 128 + wc * 32 + 8 * fq;
#pragma unroll
        for (int ai = 0; ai < 2; ++ai)
#pragma unroll
            for (int m = 0; m < 4; ++m) {
                const f32x4 g0 = acc[ai][0][m][0], g1 = acc[ai][0][m][1], u0 = acc[ai][1][m][0], u1 = acc[ai][1][m][1];
                u32x4 w; w.x = cvt_pk_bf16(siluf_(g0[0]) * u0[0], siluf_(g0[1]) * u0[1]); w.y = cvt_pk_bf16(siluf_(g0[2]) * u0[2], siluf_(g0[3]) * u0[3]);
                w.z = cvt_pk_bf16(siluf_(g1[0]) * u1[0], siluf_(g1[1]) * u1[1]); w.w = cvt_pk_bf16(siluf_(g1[2]) * u1[2], siluf_(g1[3]) * u1[3]);
                *(u32x4*)(HID + (size_t)(row0 + ai * 128 + m * 16) * DFFP + col0) = w; }
    }
};
struct EpiRes {
    static constexpr bool PERM = true; static constexpr int KIND = 0; f16_t* X; const float* xin; const float* cin; const float* modl; int midx; float coef; int first; int noop;
    __device__ __forceinline__ void operator()(ACC_T, const UnitD& u, int wr, int wc, int fr, int fq) const {
        if (noop) return;
        const int b = u.pm / TPB, j = u.pm - b * TPB;
        f16_t* dst = X + (size_t)u.pm * 256 * DM;
        const float* mv = modl + ((size_t)(j == 0 ? NB : b) * NMODV + midx) * DM;
        const int rl0 = wr * 64 + fr, col0 = u.pn * 256 + wc * 32 + 8 * fq;
        f32x4 mvv[2][2];
#pragma unroll
        for (int bj = 0; bj < 2; ++bj)
#pragma unroll
            for (int n = 0; n < 2; ++n) mvv[bj][n] = *(const f32x4*)(mv + col0 + bj * 128 + 4 * n) * coef;
        if (first) {
            const float* src = j == 0 ? cin + (size_t)b * CTXL * DM : xin + ((size_t)b * SEQ + (j - 1) * 256) * DM;
#pragma unroll
            for (int ai = 0; ai < 2; ++ai)
#pragma unroll
                for (int bj = 0; bj < 2; ++bj) {
                    f32x4 xs[4][2];
#pragma unroll
                    for (int m = 0; m < 4; ++m)
#pragma unroll
                        for (int n = 0; n < 2; ++n) xs[m][n] = *(const f32x4*)(src + (size_t)(rl0 + ai * 128 + m * 16) * DM + col0 + bj * 128 + 4 * n);
#pragma unroll
                    for (int m = 0; m < 4; ++m)
                        *(u32x4*)(dst + (size_t)(rl0 + ai * 128 + m * 16) * DM + col0 + bj * 128) = f8h(xs[m][0] + mvv[bj][0] * acc[ai][bj][m][0], xs[m][1] + mvv[bj][1] * acc[ai][bj][m][1]);
                    asm volatile("" ::: "memory");
                }
        } else {
#pragma unroll
            for (int ai = 0; ai < 2; ++ai) {
                u32x4 xs[4][2];
#pragma unroll
                for (int m = 0; m < 4; ++m)
#pragma unroll
                    for (int bj = 0; bj < 2; ++bj) xs[m][bj] = *(const u32x4*)(dst + (size_t)(rl0 + ai * 128 + m * 16) * DM + col0 + bj * 128);
#pragma unroll
                for (int m = 0; m < 4; ++m)
#pragma unroll
                    for (int bj = 0; bj < 2; ++bj) { f32x4 x0, x1; h8f(xs[m][bj], x0, x1);
                        *(u32x4*)(dst + (size_t)(rl0 + ai * 128 + m * 16) * DM + col0 + bj * 128) = f8h(x0 + mvv[bj][0] * acc[ai][bj][m][0], x1 + mvv[bj][1] * acc[ai][bj][m][1]); }
                asm volatile("" ::: "memory");
            }
        }
    }
};
struct EpiWin {
    static constexpr bool PERM = true; static constexpr int KIND = 0; bf16_t *ZA, *UGS, *GQ, *GKV, *KR;
    __device__ __forceinline__ void operator()(ACC_T, const UnitD& u, int wr, int wc, int fr, int fq) const {
        const int pn = u.pn, row0 = u.pm * 256 + wr * 64 + fr, cw = wc * 32 + 8 * fq;
        const int b = u.pm / TPB, ch0 = (u.pm - b * TPB) * 16 + 4 * wr;
#pragma unroll
        for (int ai = 0; ai < 2; ++ai)
#pragma unroll
            for (int m = 0; m < 4; ++m)
#pragma unroll
                for (int bj = 0; bj < 2; ++bj) {
                    const f32x4 v0 = acc[ai][bj][m][0], v1 = acc[ai][bj][m][1];
                    u32x4 w; w.x = cvt_pk_bf16(v0[0], v0[1]); w.y = cvt_pk_bf16(v0[2], v0[3]); w.z = cvt_pk_bf16(v1[0], v1[1]); w.w = cvt_pk_bf16(v1[2], v1[3]);
                    const int r = row0 + ai * 128 + m * 16, ct = bj * 128 + cw;
                    if (pn < 8) *(u32x4*)(ZA + (size_t)r * 2048 + pn * 256 + ct) = w;
                    else if (pn < 12) { const int cu = (pn - 8) * 256 + ct, g = cu >> 4, h0 = cu & 15, cr = b * NCH + ch0 + 8 * ai + m;
                        *(u32x4*)(UGS + ((size_t)g * CHRP + cr) * 512 + fr * 16 + h0) = w; }
                    else if (pn < 16) *(u32x4*)(GQ + (size_t)r * 1024 + (pn - 12) * 256 + ct) = w;
                    else if (pn < 18) *(u32x4*)(GKV + (size_t)r * 512 + (pn - 16) * 256 + ct) = w;
                    else if (ct < 64) *(u32x4*)(KR + (size_t)r * 64 + ct) = w;
                }
    }
};
struct EpiMlaUp {
    static constexpr bool PERM = true; static constexpr int KIND = 0; bf16_t *Q, *KV; const float* RS;
    __device__ __forceinline__ void operator()(ACC_T, const UnitD& u, int wr, int wc, int fr, int fq) const {
        const int row0 = u.pm * 256 + wr * 64 + fr, col0 = u.pn * 256 + wc * 32 + 8 * fq, tag = u.tag;
        bf16_t* O = tag ? KV : Q; const int ldc = tag ? 2048 : 1536;
#pragma unroll
        for (int ai = 0; ai < 2; ++ai)
#pragma unroll
            for (int m = 0; m < 4; ++m) { const int r = row0 + ai * 128 + m * 16; const float s = RS[(size_t)r * 2 + tag];
#pragma unroll
                for (int bj = 0; bj < 2; ++bj) { const f32x4 v0 = acc[ai][bj][m][0] * s, v1 = acc[ai][bj][m][1] * s;
                    u32x4 w; w.x = cvt_pk_bf16(v0[0], v0[1]); w.y = cvt_pk_bf16(v0[2], v0[3]); w.z = cvt_pk_bf16(v1[0], v1[1]); w.w = cvt_pk_bf16(v1[2], v1[3]);
                    *(u32x4*)(O + (size_t)r * ldc + col0 + bj * 128) = w; } }
    }
};
struct EpiGlu {
    static constexpr bool PERM = true; static constexpr int KIND = 0; bf16_t* BR; const bf16_t* YS; const float* bias;
    __device__ __forceinline__ void operator()(ACC_T, const UnitD& u, int wr, int wc, int fr, int fq) const {
        const int row0 = u.pm * 256 + wr * 64 + fr, col0 = u.pn * 256 + wc * 32 + 8 * fq;
        f32x4 bv[2][2];
#pragma unroll
        for (int bj = 0; bj < 2; ++bj)
#pragma unroll
            for (int n = 0; n < 2; ++n) bv[bj][n] = *(const f32x4*)(bias + col0 + bj * 128 + 4 * n);
#pragma unroll
        for (int ai = 0; ai < 2; ++ai)
#pragma unroll
            for (int m = 0; m < 4; ++m) { const size_t ro = (size_t)(row0 + ai * 128 + m * 16) * 1024 + col0;
#pragma unroll
                for (int bj = 0; bj < 2; ++bj) { const u32x4 y = *(const u32x4*)(YS + ro + bj * 128);
                    const f32x4 a0 = acc[ai][bj][m][0] + bv[bj][0], a1 = acc[ai][bj][m][1] + bv[bj][1];
                    u32x4 w; w.x = cvt_pk_bf16(bf_lo(y.x) * sigmoidf_(a0[0]), bf_hi(y.x) * sigmoidf_(a0[1])); w.y = cvt_pk_bf16(bf_lo(y.y) * sigmoidf_(a0[2]), bf_hi(y.y) * sigmoidf_(a0[3]));
                    w.z = cvt_pk_bf16(bf_lo(y.z) * sigmoidf_(a1[0]), bf_hi(y.z) * sigmoidf_(a1[1])); w.w = cvt_pk_bf16(bf_lo(y.w) * sigmoidf_(a1[2]), bf_hi(y.w) * sigmoidf_(a1[3]));
                    *(u32x4*)(BR + ro + bj * 128) = w; } }
    }
};
struct EpiMerge {
    static constexpr bool PERM = true; static constexpr int KIND = 0; bf16_t* Y; unsigned char* GS; const float* bgate;
    __device__ __forceinline__ void operator()(ACC_T, const UnitD& u, int wr, int wc, int fr, int fq) const {
        const int tag = u.tag, n_ = tag >> 1, row0 = u.pm * 256 + wr * 64 + fr, col0 = u.pn * 256 + wc * 32 + 8 * fq;
        unsigned char* gs = GS + (size_t)blockIdx.x * 131072 + (size_t)(((wr * 4 + wc) * 4 + fq) * 16 + fr) * 16;
        if (!(tag & 1)) {
            f32x4 bv[2][2];
#pragma unroll
            for (int bj = 0; bj < 2; ++bj)
#pragma unroll
                for (int n = 0; n < 2; ++n) bv[bj][n] = *(const f32x4*)(bgate + n_ * DM + col0 + bj * 128 + 4 * n);
#pragma unroll
            for (int ai = 0; ai < 2; ++ai)
#pragma unroll
                for (int m = 0; m < 4; ++m)
#pragma unroll
                    for (int bj = 0; bj < 2; ++bj) { const f32x4 a0 = acc[ai][bj][m][0] + bv[bj][0], a1 = acc[ai][bj][m][1] + bv[bj][1];
                        u32x4 w; w.x = cvt_pk_bf16(sigmoidf_(a0[0]), sigmoidf_(a0[1])); w.y = cvt_pk_bf16(sigmoidf_(a0[2]), sigmoidf_(a0[3]));
                        w.z = cvt_pk_bf16(sigmoidf_(a1[0]), sigmoidf_(a1[1])); w.w = cvt_pk_bf16(sigmoidf_(a1[2]), sigmoidf_(a1[3]));
                        *(u32x4*)(gs + (size_t)((ai * 4 + m) * 2 + bj) * 8192) = w; asm volatile("" ::: "memory");
                    }
        } else {
#pragma unroll
            for (int ai = 0; ai < 2; ++ai)
#pragma unroll
                for (int mh = 0; mh < 2; ++mh) {
                    u32x4 g[2][2], p[2][2];
#pragma unroll
                    for (int mm = 0; mm < 2; ++mm)
#pragma unroll
                        for (int bj = 0; bj < 2; ++bj) { const int m = mh * 2 + mm;
                            g[mm][bj] = *(const u32x4*)(gs + (size_t)((ai * 4 + m) * 2 + bj) * 8192);
                            if (n_ > 0) p[mm][bj] = *(const u32x4*)(Y + (size_t)(row0 + ai * 128 + m * 16) * DM + col0 + bj * 128); }
#pragma unroll
                    for (int mm = 0; mm < 2; ++mm)
#pragma unroll
                        for (int bj = 0; bj < 2; ++bj) { const int m = mh * 2 + mm; const u32x4 gg = g[mm][bj];
                            const f32x4 a0 = acc[ai][bj][m][0], a1 = acc[ai][bj][m][1];
                            f32x4 y0 = (f32x4){bf_lo(gg.x) * a0[0], bf_hi(gg.x) * a0[1], bf_lo(gg.y) * a0[2], bf_hi(gg.y) * a0[3]};
                            f32x4 y1 = (f32x4){bf_lo(gg.z) * a1[0], bf_hi(gg.z) * a1[1], bf_lo(gg.w) * a1[2], bf_hi(gg.w) * a1[3]};
                            if (n_ > 0) { const u32x4 pp = p[mm][bj];
                                y0 += (f32x4){bf_lo(pp.x), bf_hi(pp.x), bf_lo(pp.y), bf_hi(pp.y)}; y1 += (f32x4){bf_lo(pp.z), bf_hi(pp.z), bf_lo(pp.w), bf_hi(pp.w)}; }
                            u32x4 w; w.x = cvt_pk_bf16(y0[0], y0[1]); w.y = cvt_pk_bf16(y0[2], y0[3]); w.z = cvt_pk_bf16(y1[0], y1[1]); w.w = cvt_pk_bf16(y1[2], y1[3]);
                            *(u32x4*)(Y + (size_t)(row0 + ai * 128 + m * 16) * DM + col0 + bj * 128) = w; }
                    asm volatile("" ::: "memory");
                }
        }
    }
};
struct EpiS5A {
    static constexpr bool PERM = true; static constexpr int KIND = 0; bf16_t* E;
    __device__ __forceinline__ void operator()(ACC_T, const UnitD& u, int wr, int wc, int fr, int fq) const {
        bf16_t* base = E + ((size_t)u.pm * CHRP + u.pn * 256 + wr * 64 + fr) * 256 + wc * 32 + 8 * fq;
#pragma unroll
        for (int ai = 0; ai < 2; ++ai)
#pragma unroll
            for (int m = 0; m < 4; ++m)
#pragma unroll
                for (int bj = 0; bj < 2; ++bj) { const f32x4 v0 = acc[ai][bj][m][0], v1 = acc[ai][bj][m][1];
                    u32x4 w; w.x = cvt_pk_bf16(v0[0], v0[1]); w.y = cvt_pk_bf16(v0[2], v0[3]); w.z = cvt_pk_bf16(v1[0], v1[1]); w.w = cvt_pk_bf16(v1[2], v1[3]);
                    *(u32x4*)(base + (size_t)(ai * 128 + m * 16) * 256 + bj * 128) = w; }
    }
};
struct EpiS5C {
    static constexpr bool PERM = true; static constexpr int KIND = 0; bf16_t *YS, *GEL;
    __device__ __forceinline__ void operator()(ACC_T, const UnitD& u, int wr, int wc, int fr, int fq) const {
        const int g = u.pm;
#pragma unroll
        for (int ai = 0; ai < 2; ++ai)
#pragma unroll
            for (int m = 0; m < 4; ++m) { const int cr = u.pn * 256 + ai * 128 + wr * 64 + m * 16 + fr;
                if (cr < CHR) { const int b = cr / NCH, c = cr - b * NCH;
#pragma unroll
                    for (int bj = 0; bj < 2; ++bj) { const int n8 = bj * 128 + wc * 32 + 8 * fq, i = n8 >> 4, ho = n8 & 15;
                        const size_t o = ((size_t)b * TOK + c * 16 + i) * 1024 + g * 16 + ho;
                        const f32x4 v0 = acc[ai][bj][m][0], v1 = acc[ai][bj][m][1];
                        u32x4 w; w.x = cvt_pk_bf16(v0[0], v0[1]); w.y = cvt_pk_bf16(v0[2], v0[3]); w.z = cvt_pk_bf16(v1[0], v1[1]); w.w = cvt_pk_bf16(v1[2], v1[3]);
                        *(u32x4*)(YS + o) = w;
                        w.x = cvt_pk_bf16(gelu_tanh_(v0[0]), gelu_tanh_(v0[1])); w.y = cvt_pk_bf16(gelu_tanh_(v0[2]), gelu_tanh_(v0[3]));
                        w.z = cvt_pk_bf16(gelu_tanh_(v1[0]), gelu_tanh_(v1[1])); w.w = cvt_pk_bf16(gelu_tanh_(v1[2]), gelu_tanh_(v1[3]));
                        *(u32x4*)(GEL + o) = w; } } }
    }
};

namespace att {
constexpr int NW = 8, QBLK = 32, KVBLK = 64;
constexpr float THR = 8.f;
constexpr size_t SHM_V = KVBLK * 128 * 2, SHM_K = KVBLK * 128 * 2, SHM_KR = KVBLK * 64 * 2;
constexpr size_t OFF_V = 0, OFF_K = 3 * SHM_V, OFF_KR = OFF_K + 2 * SHM_K, OFF_WS = OFF_KR + 2 * SHM_KR, OFF_QR = OFF_WS + NW * 64 * 4, SHM_ATTN = OFF_QR + NW * 4096;
#define KSWZ(row, colB) ((row) * 256 + ((colB) ^ (((row) & 7) << 4)))
#define KRSWZ(row, colB) ((row) * 128 + ((colB) ^ ((((row) >> 1) & 7) << 4)))
#define SBAR() __builtin_amdgcn_sched_barrier(0)
__device__ __forceinline__ int crow(int r, int hi) { return (r & 3) + 8 * (r >> 2) + 4 * hi; }

template <int SCALE_ID> struct ScaleC;
template <> struct ScaleC<0> { static constexpr float SCALE = 0.07216878364870323f; };
template <> struct ScaleC<1> { static constexpr float SCALE = 0.08838834764831845f; };

template <int SID> __device__ __forceinline__ void partialSM(f32x16& p0, f32x16& p1, float& m_reg, float& mn, float& alpha) {
    constexpr float SCALE = ScaleC<SID>::SCALE, C = SCALE * 1.4426950408889634f;
    float pmax = p0[0];
#pragma unroll
    for (int r = 1; r < 16; ++r) pmax = fmaxf(pmax, p0[r]);
#pragma unroll
    for (int r = 0; r < 16; ++r) pmax = fmaxf(pmax, p1[r]);
    { auto rr = __builtin_amdgcn_permlane32_swap(__float_as_uint(pmax), __float_as_uint(pmax), false, false);
      pmax = fmaxf(__uint_as_float(rr[0]), __uint_as_float(rr[1])); }
    if (__builtin_expect(__all(pmax - m_reg <= THR / SCALE), 1)) { mn = m_reg; alpha = 1.f; }
    else { mn = fmaxf(m_reg, pmax); alpha = __builtin_amdgcn_exp2f((m_reg - mn) * C); m_reg = mn; }
    const float mnC = -mn * C;
#pragma unroll
    for (int r = 0; r < 16; ++r) p0[r] = fmaf(p0[r], C, mnC);
#pragma unroll
    for (int r = 0; r < 16; ++r) p1[r] = fmaf(p1[r], C, mnC);
#pragma unroll
    for (int r = 0; r < 16; ++r) p0[r] = __builtin_amdgcn_exp2f(p0[r]);
}
__device__ __forceinline__ void finishSM(f32x16& p0, f32x16& p1, float alpha, float& l_reg, bf16x8& pa0, bf16x8& pa1, bf16x8& pa2, bf16x8& pa3) {
#pragma unroll
    for (int r = 0; r < 16; ++r) p1[r] = __builtin_amdgcn_exp2f(p1[r]);
    float ps = 0;
#pragma unroll
    for (int r = 0; r < 16; ++r) ps += p0[r];
#pragma unroll
    for (int r = 0; r < 16; ++r) ps += p1[r];
    { auto rr = __builtin_amdgcn_permlane32_swap(__float_as_uint(ps), __float_as_uint(ps), false, false);
      ps = __uint_as_float(rr[0]) + __uint_as_float(rr[1]); }
    l_reg = l_reg * alpha + ps;
#define PK4(P, BASE, OUT) do { unsigned a0 = cvt_pk_bf16(P[BASE + 0], P[BASE + 1]), a1 = cvt_pk_bf16(P[BASE + 2], P[BASE + 3]);   \
    unsigned b0 = cvt_pk_bf16(P[BASE + 4], P[BASE + 5]), b1 = cvt_pk_bf16(P[BASE + 6], P[BASE + 7]);                              \
    auto r0 = __builtin_amdgcn_permlane32_swap(a0, b0, false, false); auto r1 = __builtin_amdgcn_permlane32_swap(a1, b1, false, false); \
    u32x4 w = {r0[0], r1[0], r0[1], r1[1]}; OUT = *reinterpret_cast<bf16x8*>(&w); } while (0)
    PK4(p0, 0, pa0); PK4(p0, 8, pa1); PK4(p1, 0, pa2); PK4(p1, 8, pa3);
#undef PK4
}
template <bool MLA> __device__ __forceinline__ void qkt(f32x16& p0, f32x16& p1, const char* Ks, const char* KRs, const bf16x8* qr, const char* qrl, int r32, int hi) {
    p0 = f32x16{}; p1 = f32x16{};
#pragma unroll
    for (int d0 = 0; d0 < 8; ++d0) { const int cb = (d0 * 16 + hi * 8) * 2;
        const bf16x8 b0 = *reinterpret_cast<const bf16x8*>(Ks + KSWZ(r32, cb));
        const bf16x8 b1 = *reinterpret_cast<const bf16x8*>(Ks + KSWZ(32 + r32, cb));
        p0 = __builtin_amdgcn_mfma_f32_32x32x16_bf16(b0, qr[d0], p0, 0, 0, 0);
        p1 = __builtin_amdgcn_mfma_f32_32x32x16_bf16(b1, qr[d0], p1, 0, 0, 0); }
    if constexpr (MLA) {
#pragma unroll
        for (int d0 = 0; d0 < 4; ++d0) { const int cb = (d0 * 16 + hi * 8) * 2;
            const bf16x8 b0 = *reinterpret_cast<const bf16x8*>(KRs + KRSWZ(r32, cb));
            const bf16x8 b1 = *reinterpret_cast<const bf16x8*>(KRs + KRSWZ(32 + r32, cb));
            const bf16x8 qf = *reinterpret_cast<const bf16x8*>(qrl + d0 * 1024);
            p0 = __builtin_amdgcn_mfma_f32_32x32x16_bf16(b0, qf, p0, 0, 0, 0);
            p1 = __builtin_amdgcn_mfma_f32_32x32x16_bf16(b1, qf, p1, 0, 0, 0); }
    }
}
__device__ __forceinline__ int v_st(int k, int c) { const int kk = (k & ~0xC) | ((k & 4) << 1) | ((k & 8) >> 1); return ((kk >> 3) * 4 + (c >> 5)) * 512 + ((kk & 7) * 32 + (c & 31)) * 2; }
__device__ __forceinline__ int v_rd_base(int lane) { return ((lane & 3) << 3) | (((lane >> 2) & 3) << 6) | (((lane >> 4) & 1) << 5) | (((lane >> 5) & 1) << 8); }
constexpr int v_rd_off(int d0, int ks, int half) { return d0 * 512 + ks * 4096 + half * 2048; }
template <int OFF> __device__ __forceinline__ s16x4 tr_read(int vb) {
    s16x4 r; asm volatile("ds_read_b64_tr_b16 %0, %1 offset:%2" : "=&v"(r) : "v"(vb), "i"(OFF) : "memory"); return r;
}
template <int D0> __device__ __forceinline__ void pv_one(f32x16& od, int vb, bf16x8 pa0, bf16x8 pa1, bf16x8 pa2, bf16x8 pa3) {
    const s16x4 l0 = tr_read<v_rd_off(D0, 0, 0)>(vb), h0 = tr_read<v_rd_off(D0, 0, 1)>(vb), l1 = tr_read<v_rd_off(D0, 1, 0)>(vb), h1 = tr_read<v_rd_off(D0, 1, 1)>(vb);
    const s16x4 l2 = tr_read<v_rd_off(D0, 2, 0)>(vb), h2 = tr_read<v_rd_off(D0, 2, 1)>(vb), l3 = tr_read<v_rd_off(D0, 3, 0)>(vb), h3 = tr_read<v_rd_off(D0, 3, 1)>(vb);
    asm volatile("s_waitcnt lgkmcnt(0)" ::: "memory"); SBAR();
#define PK(L, H) (bf16x8){L[0], L[1], L[2], L[3], H[0], H[1], H[2], H[3]}
    od = __builtin_amdgcn_mfma_f32_32x32x16_bf16(pa0, PK(l0, h0), od, 0, 0, 0);
    od = __builtin_amdgcn_mfma_f32_32x32x16_bf16(pa1, PK(l1, h1), od, 0, 0, 0);
    od = __builtin_amdgcn_mfma_f32_32x32x16_bf16(pa2, PK(l2, h2), od, 0, 0, 0);
    od = __builtin_amdgcn_mfma_f32_32x32x16_bf16(pa3, PK(l3, h3), od, 0, 0, 0);
#undef PK
}
__device__ __forceinline__ void pv_d0(f32x16* o, int vb, bf16x8 pa0, bf16x8 pa1, bf16x8 pa2, bf16x8 pa3) {
    pv_one<0>(o[0], vb, pa0, pa1, pa2, pa3); pv_one<1>(o[1], vb, pa0, pa1, pa2, pa3); pv_one<2>(o[2], vb, pa0, pa1, pa2, pa3); pv_one<3>(o[3], vb, pa0, pa1, pa2, pa3);
}
__device__ __forceinline__ void rope_pair(bf16x8& f1, bf16x8& f2, const float* tp) {
    const u32x4 a = *reinterpret_cast<u32x4*>(&f1), b = *reinterpret_cast<u32x4*>(&f2);
    const f32x4 t0 = *(const f32x4*)(tp), t1 = *(const f32x4*)(tp + 4), t2 = *(const f32x4*)(tp + 8), t3 = *(const f32x4*)(tp + 12);
    const float c[8] = {t0[0], t0[2], t1[0], t1[2], t2[0], t2[2], t3[0], t3[2]}, s[8] = {t0[1], t0[3], t1[1], t1[3], t2[1], t2[3], t3[1], t3[3]};
    const float x1[8] = {bf_lo(a.x), bf_hi(a.x), bf_lo(a.y), bf_hi(a.y), bf_lo(a.z), bf_hi(a.z), bf_lo(a.w), bf_hi(a.w)};
    const float x2[8] = {bf_lo(b.x), bf_hi(b.x), bf_lo(b.y), bf_hi(b.y), bf_lo(b.z), bf_hi(b.z), bf_lo(b.w), bf_hi(b.w)};
    float o1[8], o2[8];
#pragma unroll
    for (int j = 0; j < 8; ++j) { o1[j] = x1[j] * c[j] - x2[j] * s[j]; o2[j] = x2[j] * c[j] + x1[j] * s[j]; }
    u32x4 wa = {cvt_pk_bf16(o1[0], o1[1]), cvt_pk_bf16(o1[2], o1[3]), cvt_pk_bf16(o1[4], o1[5]), cvt_pk_bf16(o1[6], o1[7])};
    u32x4 wb = {cvt_pk_bf16(o2[0], o2[1]), cvt_pk_bf16(o2[2], o2[3]), cvt_pk_bf16(o2[4], o2[5]), cvt_pk_bf16(o2[6], o2[7])};
    f1 = *reinterpret_cast<bf16x8*>(&wa); f2 = *reinterpret_cast<bf16x8*>(&wb);
}
struct AttnP { const bf16_t *Q, *KV, *KR, *GQ, *GKV; bf16_t *OMLA, *OGQA; const float *ROPEG, *ROPEM, *gq; };

template <bool MLA>
__device__ __forceinline__ void attn_unit(const AttnP& P, int b, int h, int qb, char* lds) {
    constexpr int SID = MLA ? 0 : 1;
    constexpr int LDQ = MLA ? 1536 : 1024, LDK = MLA ? 2048 : 512, LDO = 1024;
    int tid = threadIdx.x; asm volatile("" : "+v"(tid));
    const int wid = __builtin_amdgcn_readfirstlane(tid >> 6), lane = tid & 63, r32 = lane & 31, hi = lane >> 5;
    const size_t rowbase = (size_t)b * TOK + (size_t)qb * 256, keybase = (size_t)b * TOK;
    const int seq = qb == 0 ? CTXL : TOK;
    const bf16_t* Qb = MLA ? P.Q + rowbase * LDQ + h * 192 : P.GQ + rowbase * LDQ + h * 128;
    const bf16_t* Kh = MLA ? P.KV + keybase * LDK + h * 256 : P.GKV + keybase * LDK + (h >> 2) * 128;
    const bf16_t* Vh = MLA ? Kh + 128 : Kh + 256;
    const bf16_t* KRp = P.KR + keybase * 64;
    bf16_t* Ob = (MLA ? P.OMLA : P.OGQA) + rowbase * LDO + h * 128;
    char* V_lds = lds + OFF_V; char* K_lds = lds + OFF_K; char* KR_lds = lds + OFF_KR;
    float* ws = (float*)(lds + OFF_WS) + wid * 64; float* li_l = ws; float* al_l = ws + 32;
    char* qrl = lds + OFF_QR + wid * 4096 + lane * 16;
    float m_reg = -1e30f, l_reg = 0; f32x16 o[4] = {}; bf16x8 qr[8];
    unsigned koff0, koff1, kroff, voff0, voff1;
    { const int p0 = (wid * 2) * 64 + lane, p1 = p0 + 64;
      { const int row = p0 >> 4, c = (p0 & 15) ^ (row & 7); koff0 = (unsigned)(row * LDK + c * 8); }
      { const int row = p1 >> 4, c = (p1 & 15) ^ (row & 7); koff1 = (unsigned)(row * LDK + c * 8); }
      { const int row = wid * 8 + (lane >> 3), c = (lane & 7) ^ ((row >> 1) & 7); kroff = (unsigned)(row * 64 + c * 8); }
      { const int s_ = p0 >> 5, u_ = p0 & 31, kk = (s_ >> 2) * 8 + (u_ >> 2), k = (kk & ~0xC) | ((kk & 4) << 1) | ((kk & 8) >> 1); voff0 = (unsigned)(k * LDK + (s_ & 3) * 32 + (u_ & 3) * 8); }
      { const int s_ = p1 >> 5, u_ = p1 & 31, kk = (s_ >> 2) * 8 + (u_ >> 2), k = (kk & ~0xC) | ((kk & 4) << 1) | ((kk & 8) >> 1); voff1 = (unsigned)(k * LDK + (s_ & 3) * 32 + (u_ & 3) * 8); } }
    LAS unsigned char* ldsl = (LAS unsigned char*)lds;
    const unsigned wk = (unsigned)__builtin_amdgcn_readfirstlane(wid) * 2048u, wkr = (unsigned)__builtin_amdgcn_readfirstlane(wid) * 1024u;
#define GLDS16(gp, ldsoff) __builtin_amdgcn_global_load_lds((const unsigned*)(gp), (LAS unsigned*)(ldsl + (ldsoff)), 16, 0, 0)
#define SISSUE(k0, kb, vbo) do { const bf16_t* kt_ = Kh + (size_t)(k0) * LDK; const bf16_t* vt_ = Vh + (size_t)(k0) * LDK;                         \
    GLDS16(kt_ + koff0, OFF_K + (kb) * SHM_K + wk); GLDS16(kt_ + koff1, OFF_K + (kb) * SHM_K + wk + 1024u);                                      \
    if constexpr (MLA) GLDS16(KRp + (size_t)(k0) * 64 + kroff, OFF_KR + (kb) * SHM_KR + wkr);                                                     \
    GLDS16(vt_ + voff0, OFF_V + (vbo) + wk); GLDS16(vt_ + voff1, OFF_V + (vbo) + wk + 1024u); } while (0)
#define RESC(a) do { if (__any((a) < 1.f)) { if (hi == 0) al_l[r32] = (a); asm volatile("s_waitcnt lgkmcnt(0)" ::: "memory"); \
    _Pragma("unroll") for (int d = 0; d < 4; ++d) _Pragma("unroll") for (int r = 0; r < 16; ++r) o[d][r] *= al_l[crow(r, hi)]; } } while (0)
    const int vbl = (int)(uintptr_t)V_lds + v_rd_base(lane);
    f32x16 pA0, pA1, pB0, pB1; float mnA, mnB, alA, alB; bf16x8 pa0, pa1, pa2, pa3; const int NT = seq / KVBLK;
    unsigned vprev = 0u, vcur = (unsigned)SHM_V, vnext = 2u * (unsigned)SHM_V;
    {
        const int qrow = wid * QBLK + r32;
        const bf16_t* Qw = Qb + (size_t)qrow * LDQ + hi * 8;
#pragma unroll
        for (int d0 = 0; d0 < 8; ++d0) qr[d0] = *reinterpret_cast<const bf16x8*>(Qw + d0 * 16);
        bf16x8 q8, q9, q10, q11;
        if constexpr (MLA) { q8 = *reinterpret_cast<const bf16x8*>(Qw + 128); q9 = *reinterpret_cast<const bf16x8*>(Qw + 144); q10 = *reinterpret_cast<const bf16x8*>(Qw + 160); q11 = *reinterpret_cast<const bf16x8*>(Qw + 176); }
        SISSUE(0, 0, 0u); SISSUE(KVBLK, 1, (unsigned)SHM_V);
        const int t = (qb - 1) * 256 + qrow, prow = t >> 6, pcol = t & 63;
        if constexpr (!MLA) {
            float ss = 0.f;
#pragma unroll
            for (int d0 = 0; d0 < 8; ++d0) { const u32x4 a = *reinterpret_cast<u32x4*>(&qr[d0]);
                const float x[8] = {bf_lo(a.x), bf_hi(a.x), bf_lo(a.y), bf_hi(a.y), bf_lo(a.z), bf_hi(a.z), bf_lo(a.w), bf_hi(a.w)};
#pragma unroll
                for (int j = 0; j < 8; ++j) ss += x[j] * x[j]; }
            ss += __shfl_xor(ss, 32);
            const float rstd = rsqrtf(ss * (1.f / 128.f) + EPS);
#pragma unroll
            for (int d0 = 0; d0 < 8; ++d0) { const u32x4 a = *reinterpret_cast<u32x4*>(&qr[d0]);
                const f32x4 g0 = *(const f32x4*)(P.gq + d0 * 16 + hi * 8), g1 = *(const f32x4*)(P.gq + d0 * 16 + hi * 8 + 4);
                u32x4 w; w.x = cvt_pk_bf16(bf_lo(a.x) * rstd * g0[0], bf_hi(a.x) * rstd * g0[1]); w.y = cvt_pk_bf16(bf_lo(a.y) * rstd * g0[2], bf_hi(a.y) * rstd * g0[3]);
                w.z = cvt_pk_bf16(bf_lo(a.z) * rstd * g1[0], bf_hi(a.z) * rstd * g1[1]); w.w = cvt_pk_bf16(bf_lo(a.w) * rstd * g1[2], bf_hi(a.w) * rstd * g1[3]);
                qr[d0] = *reinterpret_cast<bf16x8*>(&w); }
            if (qb > 0) {
                const float* tr = P.ROPEG + (size_t)prow * 64 + hi * 16; const float* tc = P.ROPEG + (size_t)pcol * 64 + hi * 16;
                rope_pair(qr[0], qr[2], tr); rope_pair(qr[1], qr[3], tr + 32); rope_pair(qr[4], qr[6], tc); rope_pair(qr[5], qr[7], tc + 32);
            }
        } else {
            if (qb > 0) {
                const float* tr = P.ROPEM + (size_t)prow * 32 + hi * 16; const float* tc = P.ROPEM + (size_t)pcol * 32 + hi * 16;
                rope_pair(q8, q9, tr); rope_pair(q10, q11, tc);
            }
            *reinterpret_cast<bf16x8*>(qrl) = q8; *reinterpret_cast<bf16x8*>(qrl + 1024) = q9; *reinterpret_cast<bf16x8*>(qrl + 2048) = q10; *reinterpret_cast<bf16x8*>(qrl + 3072) = q11;
            asm volatile("s_waitcnt lgkmcnt(0)" ::: "memory");
        }
    }
    VM_WAIT(); __syncthreads();
    qkt<MLA>(pA0, pA1, K_lds, KR_lds, qr, qrl, r32, hi); partialSM<SID>(pA0, pA1, m_reg, mnA, alA);
    __syncthreads();
    for (int j = 1; j + 1 < NT; j += 2) {
        SBAR(); qkt<MLA>(pB0, pB1, K_lds + SHM_K, KR_lds + SHM_KR, qr, qrl, r32, hi);
        finishSM(pA0, pA1, alA, l_reg, pa0, pa1, pa2, pa3); SBAR();
        SISSUE((j + 1) * KVBLK, 0, vnext); SBAR();
        pv_d0(o, vbl + (int)vprev, pa0, pa1, pa2, pa3); partialSM<SID>(pB0, pB1, m_reg, mnB, alB);
        RESC(alB); VM_WAIT(); __syncthreads();
        { const unsigned t_ = vprev; vprev = vcur; vcur = vnext; vnext = t_; }
        SBAR(); qkt<MLA>(pA0, pA1, K_lds, KR_lds, qr, qrl, r32, hi);
        finishSM(pB0, pB1, alB, l_reg, pa0, pa1, pa2, pa3); SBAR();
        if (j + 2 < NT) SISSUE((j + 2) * KVBLK, 1, vnext); SBAR();
        pv_d0(o, vbl + (int)vprev, pa0, pa1, pa2, pa3); partialSM<SID>(pA0, pA1, m_reg, mnA, alA);
        RESC(alA); VM_WAIT(); __syncthreads();
        { const unsigned t_ = vprev; vprev = vcur; vcur = vnext; vnext = t_; }
    }
    SBAR(); qkt<MLA>(pB0, pB1, K_lds + SHM_K, KR_lds + SHM_KR, qr, qrl, r32, hi);
    finishSM(pA0, pA1, alA, l_reg, pa0, pa1, pa2, pa3); SBAR();
    pv_d0(o, vbl + (int)vprev, pa0, pa1, pa2, pa3); partialSM<SID>(pB0, pB1, m_reg, mnB, alB);
    RESC(alB);
    finishSM(pB0, pB1, alB, l_reg, pa0, pa1, pa2, pa3); SBAR();
    pv_d0(o, vbl + (int)vcur, pa0, pa1, pa2, pa3);
    if (hi == 0) li_l[r32] = l_reg; asm volatile("s_waitcnt lgkmcnt(0)" ::: "memory");
    float rli[16];
#pragma unroll
    for (int r = 0; r < 16; ++r) rli[r] = __builtin_amdgcn_rcpf(li_l[crow(r, hi)]);
    __syncthreads();
    int lane2 = lane; asm volatile("" : "+v"(lane2));
    const int r32b = lane2 & 31, hib = lane2 >> 5;
    char* ot = lds + (size_t)wid * (32 * 272);
#pragma unroll
    for (int r = 0; r < 16; ++r) { const int orow = crow(r, hib);
#pragma unroll
        for (int d0 = 0; d0 < 4; ++d0) *(bf16_t*)(ot + orow * 272 + (d0 * 32 + r32b) * 2) = f2bf(o[d0][r] * rli[r]); }
    asm volatile("s_waitcnt lgkmcnt(0)" ::: "memory");
#pragma unroll
    for (int it = 0; it < 8; ++it) { const int ch = it * 64 + lane2, row = ch >> 4, c16 = ch & 15;
        const u32x4 w = *(const u32x4*)(ot + row * 272 + c16 * 16);
        *(u32x4*)(Ob + (size_t)(wid * QBLK + row) * LDO + c16 * 8) = w; }
    __syncthreads();
#undef GLDS16
#undef SISSUE
#undef RESC
}
}

struct Args { const float* in[31]; float* out; unsigned char* ws; int ph_lo, ph_hi; };
typedef const __attribute__((address_space(4))) Args* KArgs;
__device__ __forceinline__ KArgs kargs() { KArgs p = (KArgs)__builtin_amdgcn_kernarg_segment_ptr(); asm volatile("" : "+s"(p)); return p; }

__device__ __forceinline__ void phase_pre(KArgs a, LAS unsigned char* lds, int G) {
    int tidx_ = threadIdx.x; asm volatile("" : "+v"(tidx_));
    const int tid = tidx_;
    const float* c = a->in[1]; const float* cctx = a->in[3]; const float* wmod = a->in[4]; const float* bmod = a->in[5];
    float* MOD = (float*)(a->ws + WS_MOD);
    LAS float* sS = (LAS float*)lds;
    LAS float* sP = (LAS float*)(lds + 73728);
    for (int i = tid; i < 9 * 2048; i += 512) { const int r = i >> 11, k = i & 2047; const float v = r < 8 ? c[r * 2048 + k] : cctx[k]; sS[i] = siluf_(v); }
    __syncthreads();
    for (int item = blockIdx.x; item < 256; item += G) {
        const int l = item >> 7, c4b = (item & 127) * 36;
        const int cq = tid % 36, ks = tid / 36;
        f32x4 accv[9];
#pragma unroll
        for (int r = 0; r < 9; ++r) accv[r] = (f32x4){0.f, 0.f, 0.f, 0.f};
        if (ks < 14) {
            const float* wp = wmod + (size_t)l * 2048 * 18432 + (size_t)(c4b + cq) * 4;
            for (int k = ks; k < 2048; k += 14 * 8) {
                f32x4 w[8];
#pragma unroll
                for (int q = 0; q < 8; ++q) { const int kk = k + 14 * q; w[q] = kk < 2048 ? *(const f32x4*)(wp + (size_t)kk * 18432) : (f32x4){0.f, 0.f, 0.f, 0.f}; }
#pragma unroll
                for (int q = 0; q < 8; ++q) { const int kk = (k + 14 * q) < 2048 ? (k + 14 * q) : 0;
#pragma unroll
                    for (int r = 0; r < 9; ++r) accv[r] += w[q] * sS[r * 2048 + kk]; } }
#pragma unroll
            for (int r = 0; r < 9; ++r) *(LAS f32x4*)(sP + ((ks * 36 + cq) * 9 + r) * 4) = accv[r];
        }
        __syncthreads();
        for (int o = tid; o < 36 * 9 * 4; o += 512) { const int cq2 = o / 36, rem = o - cq2 * 36;
            float s = 0.f;
            for (int k2 = 0; k2 < 14; ++k2) s += sP[(k2 * 36 + cq2) * 36 + rem];
            const int r = rem >> 2, e = rem & 3, col = (c4b + cq2) * 4 + e;
            MOD[((size_t)(l * 9 + r) * 9) * 2048 + col] = s + bmod[(size_t)l * 18432 + col];
        }
        __syncthreads();
    }
    float* RG = (float*)(a->ws + WS_ROPEG); float* RM = (float*)(a->ws + WS_ROPEM);
    for (int i = blockIdx.x * 512 + tid; i < 64 * 32 + 64 * 16; i += G * 512) {
        if (i < 2048) { const int pos = i >> 5, f = i & 31; const float fr = powf(10000.0f, -(float)(2 * f) / 64.0f), ang = (float)pos * fr; RG[i * 2] = cosf(ang); RG[i * 2 + 1] = sinf(ang); }
        else { const int k = i - 2048, pos = k >> 4, f = k & 15; const float fr = powf(10000.0f, -(float)(2 * f) / 32.0f), ang = (float)pos * fr; RM[k * 2] = cosf(ang); RM[k * 2 + 1] = sinf(ang); }
    }
}

__device__ __forceinline__ int conv_row_map(int kind, int n0) {
    if (kind == 1) return n0 < DFF ? (n0 >> 7) * 256 + (n0 & 127) : ((n0 - DFF) >> 7) * 256 + 128 + ((n0 - DFF) & 127);
    if (kind == 2) { if (n0 < 2048) return n0; if (n0 < 2112) return 4608 + (n0 - 2048); return n0 - 64; }
    return n0;
}
__device__ __forceinline__ void conv_item(const float* W, int K, int N, bf16_t* WT, int kind, const float* kscale, LAS float* scr, int item, int lane, int KP = 0) {
    if (KP == 0) KP = K;
    const int nblk = N >> 6, kb = item / nblk, nb = item - kb * nblk, k0 = kb * 64, n0 = nb * 64;
    const float* wp = W + (size_t)k0 * N + n0 + lane;
#pragma unroll
    for (int h = 0; h < 2; ++h) {
        float v[32];
#pragma unroll
        for (int i = 0; i < 32; ++i) v[i] = wp[(size_t)(h * 32 + i) * N];
        if (kscale) {
#pragma unroll
            for (int i = 0; i < 32; ++i) v[i] *= kscale[k0 + h * 32 + i]; }
#pragma unroll
        for (int i = 0; i < 32; ++i) scr[(h * 32 + i) * 65 + lane] = v[i];
    }
    LDS_WAIT(); asm volatile("" ::: "memory");
    const int cch = lane & 7, drow0 = conv_row_map(kind, n0);
#pragma unroll
    for (int j = 0; j < 8; ++j) { const int n = (lane >> 3) + 8 * j; const LAS float* s = scr + (8 * cch) * 65 + n;
        u32x4 o; o.x = cvt_pk_bf16(s[0], s[65]); o.y = cvt_pk_bf16(s[2 * 65], s[3 * 65]); o.z = cvt_pk_bf16(s[4 * 65], s[5 * 65]); o.w = cvt_pk_bf16(s[6 * 65], s[7 * 65]);
        *(u32x4*)(WT + (size_t)(drow0 + n) * KP + k0 + 8 * cch) = o; }
    LDS_WAIT(); asm volatile("" ::: "memory");
}
namespace cv { constexpr int I_UP = 32 * 176, I_DN = 88 * 32, I_WIN = 32 * 73, I_UQ = 24 * 24, I_UKV = 8 * 32, I_GLU = 16 * 16, I_G = 32 * 32, I_BR = 16 * 32, I_O = 32 * 32;
    constexpr int CV_A = 2 * I_UP + I_DN, CV_B = CV_A + I_WIN + I_UQ + I_UKV + I_GLU + 3 * I_G, CV_C = CV_B + 3 * I_BR + I_O, CV_N = CV_C + I_DN; }
__device__ __forceinline__ void phase_conv(KArgs a, int l, LAS unsigned char* lds, int G, int lo, int hi, int slo, int shi, int cu0, int tail) {
    using namespace cv;
    int tidx_ = threadIdx.x; asm volatile("" : "+v"(tidx_));
    const int tid = tidx_, lane = tid & 63, wave = tid >> 6, gw = ((int)blockIdx.x - cu0) * 8 + wave, NGW = (G - cu0) * 8;
    LAS float* scr = (LAS float*)(lds + wave * 16640);
    bf16_t* WB = (bf16_t*)(a->ws + WS_WB);
    const float* up = a->in[7] + (size_t)l * 2 * 2048 * 11264; const float* dn = a->in[8] + (size_t)l * 2 * 5632 * 2048;
    const float* win = a->in[9] + (size_t)l * 2048 * 4672; const float* wuq = a->in[12] + (size_t)l * 1536 * 1536; const float* wukv = a->in[13] + (size_t)l * 512 * 2048;
    const float* wglu = a->in[24] + (size_t)l * 1024 * 1024; const float* wg = a->in[26] + (size_t)l * 3 * 2048 * 2048; const float* wbr = a->in[28] + (size_t)l * 3 * 1024 * 2048;
    const float* wo = a->in[29] + (size_t)l * 2048 * 2048;
    for (int it = lo + gw; it < hi; it += NGW) {
        if (it >= slo && it < shi) continue;
        int r = it;
        if (r < I_UP) { conv_item(up, 2048, 11264, WB + WB_UP0, 1, nullptr, scr, r, lane); continue; } r -= I_UP;
        if (r < I_DN) { conv_item(dn, 5632, 2048, WB + WB_DN0, 0, nullptr, scr, r, lane, DFFP); continue; } r -= I_DN;
        if (r < I_UP) { conv_item(up + (size_t)2048 * 11264, 2048, 11264, WB + WB_UP1, 1, nullptr, scr, r, lane); continue; } r -= I_UP;
        if (r < I_WIN) { conv_item(win, 2048, 4672, WB + WB_WIN, 2, nullptr, scr, r, lane); continue; } r -= I_WIN;
        if (r < I_UQ) { conv_item(wuq, 1536, 1536, WB + WB_WUQ, 0, a->in[10] + l * 1536, scr, r, lane); continue; } r -= I_UQ;
        if (r < I_UKV) { conv_item(wukv, 512, 2048, WB + WB_WUKV, 0, a->in[11] + l * 512, scr, r, lane); continue; } r -= I_UKV;
        if (r < I_GLU) { conv_item(wglu, 1024, 1024, WB + WB_WGLU, 0, nullptr, scr, r, lane); continue; } r -= I_GLU;
        if (r < 3 * I_G) { const int n = r / I_G; conv_item(wg + (size_t)n * 2048 * 2048, 2048, 2048, WB + WB_WG + (size_t)n * 2048 * 2048, 0, nullptr, scr, r - n * I_G, lane); continue; } r -= 3 * I_G;
        if (r < 3 * I_BR) { const int n = r / I_BR; conv_item(wbr + (size_t)n * 1024 * 2048, 1024, 2048, WB + WB_WBR + (size_t)n * 2048 * 1024, 0, nullptr, scr, r - n * I_BR, lane); continue; } r -= 3 * I_BR;
        if (r < I_O) { conv_item(wo, 2048, 2048, WB + WB_WO, 0, nullptr, scr, r, lane); continue; } r -= I_O;
        conv_item(dn + (size_t)5632 * 2048, 5632, 2048, WB + WB_DN1, 0, nullptr, scr, r, lane, DFFP);
    }
    if (!tail) return;
    const int ti0 = ((int)blockIdx.x - cu0) * 512 + tid, tst = (G - cu0) * 512;
    { u32x4* z = (u32x4*)(WB + WB_WIN + (size_t)4672 * 2048); const int n16 = 192 * 2048 * 2 / 16;
      unsigned zz = 0u; asm volatile("" : "+v"(zz));
      for (int i = ti0; i < n16; i += tst) z[i] = (u32x4){zz, zz, zz, zz}; }
    {
        f32x2* Pt = (f32x2*)(a->ws + WS_S5P); f32x2* BBt = (f32x2*)(a->ws + WS_S5BB);
        const float* lre = a->in[16] + (size_t)l * 2 * 64 * 64; const float* lim = a->in[17] + (size_t)l * 2 * 64 * 64; const float* ldt = a->in[18] + (size_t)l * 2 * 64;
        const float* bre = a->in[19] + (size_t)l * 2 * 64 * 64 * 16; const float* bim = a->in[20] + (size_t)l * 2 * 64 * 64 * 16;
        for (int i = ti0; i < 8192; i += tst) {
            const int p = i & 63, g = (i >> 6) & 63, d = i >> 12;
            const float lr = fminf(lre[i], -1e-4f), li = lim[i], dt = expf(ldt[d * 64 + g]);
            const size_t o = ((size_t)(g * 2 + d) * 64 + p);
            for (int n = 0; n <= 16; ++n) { const float mg = expf(lr * dt * (float)n), an = li * dt * (float)n; Pt[o * 17 + n] = (f32x2){mg * cosf(an), mg * sinf(an)}; }
            const float th = li * dt, ct = cosf(th), st = sinf(th), sh = sinf(0.5f * th);
            const float nr = expm1f(lr * dt) * ct - 2.f * sh * sh, ni = expf(lr * dt) * st, den = lr * lr + li * li;
            const float f_r = (nr * lr + ni * li) / den, f_i = (ni * lr - nr * li) / den;
            for (int h = 0; h < 16; ++h) { const float br = bre[(size_t)i * 16 + h], bi = bim[(size_t)i * 16 + h]; BBt[o * 16 + h] = (f32x2){f_r * br - f_i * bi, f_r * bi + f_i * br}; }
        }
    }
}
__device__ __forceinline__ void s5_pass2(KArgs a, int l, int G) {
    int tidx_ = threadIdx.x; asm volatile("" : "+v"(tidx_));
    const f32x2* Pt = (const f32x2*)(a->ws + WS_S5P); const f32x2* BBt = (const f32x2*)(a->ws + WS_S5BB); float* KT = (float*)(a->ws + WS_S5K);
    const float* cre = a->in[21] + (size_t)l * 2 * 64 * 16 * 64; const float* cim = a->in[22] + (size_t)l * 2 * 64 * 16 * 64;
    for (int i = blockIdx.x * 512 + tidx_; i < 64 * 2 * 16 * 256; i += G * 512) {
        const int hi_ = i & 15, ho = (i >> 4) & 15, tau = (i >> 8) & 15, d = (i >> 12) & 1, g = i >> 13;
        const size_t o = (size_t)(g * 2 + d) * 64; const float* cr = cre + ((size_t)(d * 64 + g) * 16 + ho) * 64; const float* ci = cim + ((size_t)(d * 64 + g) * 16 + ho) * 64;
        float s = 0.f;
        for (int p = 0; p < 64; ++p) { const f32x2 pw = Pt[(o + p) * 17 + tau], bb = BBt[(o + p) * 16 + hi_];
            const float xr = pw.x * bb.x - pw.y * bb.y, xi = pw.x * bb.y + pw.y * bb.x; s += cr[p] * xr - ci[p] * xi; }
        KT[i] = s;
    }
}
__device__ __forceinline__ void s5_pass3(KArgs a, int l, int G) {
    int tidx_ = threadIdx.x; asm volatile("" : "+v"(tidx_));
    const f32x2* Pt = (const f32x2*)(a->ws + WS_S5P); const f32x2* BBt = (const f32x2*)(a->ws + WS_S5BB); const float* KT = (const float*)(a->ws + WS_S5K);
    const float* cre = a->in[21] + (size_t)l * 2 * 64 * 16 * 64; const float* cim = a->in[22] + (size_t)l * 2 * 64 * 16 * 64; const float* dsk = a->in[23] + (size_t)l * 64 * 16;
    bf16_t* WE = (bf16_t*)(a->ws + WS_WE); bf16_t* WC = (bf16_t*)(a->ws + WS_WC);
    constexpr int NE = 64 * 256 * 32, NC = 64 * 256 * 64;
    for (int i = blockIdx.x * 512 + tidx_; i < NE + NC; i += G * 512) {
        float v[8];
        if (i < NE) {
            const int k8 = i & 31, n = (i >> 5) & 255, g = i >> 13, d = n >> 7, p = (n >> 1) & 63, ri = n & 1, j = k8 >> 1, h0 = (k8 & 1) * 8, e = d == 0 ? 15 - j : j;
            const size_t o = (size_t)(g * 2 + d) * 64 + p; const f32x2 pw = Pt[o * 17 + e];
#pragma unroll
            for (int q = 0; q < 8; ++q) { const f32x2 bb = BBt[o * 16 + h0 + q]; v[q] = ri == 0 ? pw.x * bb.x - pw.y * bb.y : pw.x * bb.y + pw.y * bb.x; }
            u32x4 w; w.x = cvt_pk_bf16(v[0], v[1]); w.y = cvt_pk_bf16(v[2], v[3]); w.z = cvt_pk_bf16(v[4], v[5]); w.w = cvt_pk_bf16(v[6], v[7]);
            *(u32x4*)(WE + (size_t)i * 8) = w;
        } else {
            const int ii = i - NE, k8 = ii & 63, n = (ii >> 6) & 255, g = ii >> 14, ti = n >> 4, ho = n & 15;
            if (k8 < 32) { const int j = k8 >> 1, h0 = (k8 & 1) * 8;
#pragma unroll
                for (int q = 0; q < 8; ++q) { const int hi_ = h0 + q; float s = 0.f;
                    if (j <= ti) s += KT[((size_t)((g * 2 + 0) * 16 + (ti - j)) * 16 + ho) * 16 + hi_];
                    if (j >= ti) s += KT[((size_t)((g * 2 + 1) * 16 + (j - ti)) * 16 + ho) * 16 + hi_];
                    if (j == ti && hi_ == ho) s += dsk[g * 16 + ho];
                    v[q] = s; }
            } else { const int d = (k8 - 32) >> 4, p0 = ((k8 - 32) & 15) * 4, e = d == 0 ? ti + 1 : 16 - ti;
#pragma unroll
                for (int q = 0; q < 4; ++q) { const int p = p0 + q; const f32x2 pw = Pt[((size_t)(g * 2 + d) * 64 + p) * 17 + e];
                    const float cr = cre[((size_t)(d * 64 + g) * 16 + ho) * 64 + p], ci = cim[((size_t)(d * 64 + g) * 16 + ho) * 64 + p];
                    v[2 * q] = cr * pw.x - ci * pw.y; v[2 * q + 1] = -(cr * pw.y + ci * pw.x); }
            }
            u32x4 w; w.x = cvt_pk_bf16(v[0], v[1]); w.y = cvt_pk_bf16(v[2], v[3]); w.z = cvt_pk_bf16(v[4], v[5]); w.w = cvt_pk_bf16(v[6], v[7]);
            *(u32x4*)(WC + (size_t)ii * 8) = w;
        }
    }
}
__device__ __forceinline__ void phase_norm(KArgs a, int l, int gi, int si, int sci, int first, int mode, int cu0, int NGW) {
    int tidx_ = threadIdx.x; asm volatile("" : "+v"(tidx_));
    int bidx_ = blockIdx.x; asm volatile("" : "+s"(bidx_), "+s"(NGW));
    const int lane = tidx_ & 63, gw = (bidx_ - cu0) * 8 + (tidx_ >> 6);
    const f16_t* X = (const f16_t*)(a->ws + WS_X); bf16_t* H = (bf16_t*)(a->ws + WS_H);
    const float* gv = a->in[6] + ((size_t)l * 3 + gi) * DM; const float* modl = (const float*)(a->ws + WS_MOD) + (size_t)l * 9 * 9 * DM;
    const int nwl = mode == 0 ? (NGW * 2) / 17 : (mode == 1 ? NGW / 8 : 0), nwc = mode == 0 ? NGW - 8 * nwl : (mode == 2 ? NGW : 0);
    int mr, wi, nw, nrows;
    if (gw < 8 * nwl) { mr = gw / nwl; wi = gw - mr * nwl; nw = nwl; nrows = SEQ; } else { mr = NB; wi = gw - 8 * nwl; nw = nwc; nrows = NB * CTXL; }
    if (gw < 0 || nw <= 0 || wi >= nw) return;
    const float* mrow = modl + (size_t)mr * 9 * DM;
    f32x4 gm[8], sh[8];
#pragma unroll
    for (int j = 0; j < 8; ++j) { const int c = (lane + 64 * (j >> 1)) * 8 + 4 * (j & 1); gm[j] = *(const f32x4*)(gv + c) * (*(const f32x4*)(mrow + (size_t)sci * DM + c) + 1.0f); sh[j] = *(const f32x4*)(mrow + (size_t)si * DM + c); }
    const float* xin = a->in[0]; const float* cin = a->in[2];
#define NORM_ROW(i, rr, sp) do { if (mr < NB) { rr = (size_t)mr * TOK + CTXL + (i); sp = xin + ((size_t)mr * SEQ + (i)) * DM; } \
        else { const int b_ = (i) >> 8, t_ = (i) & 255; rr = (size_t)b_ * TOK + t_; sp = cin + ((size_t)b_ * CTXL + t_) * DM; } } while (0)
#define NORM_OUT(v) do { float s = 0.f; \
        _Pragma("unroll") for (int j = 0; j < 8; ++j) s += (v[j].x * v[j].x + v[j].y * v[j].y) + (v[j].z * v[j].z + v[j].w * v[j].w); \
        const float rstd = rsqrtf(wave_sum(s) * (1.f / DM) + EPS); \
        _Pragma("unroll") for (int j = 0; j < 4; ++j) { const f32x4 y0 = (v[2 * j] * rstd) * gm[2 * j] + sh[2 * j], y1 = (v[2 * j + 1] * rstd) * gm[2 * j + 1] + sh[2 * j + 1]; \
            u32x4 w; w.x = cvt_pk_bf16(y0.x, y0.y); w.y = cvt_pk_bf16(y0.z, y0.w); w.z = cvt_pk_bf16(y1.x, y1.y); w.w = cvt_pk_bf16(y1.z, y1.w); \
            *(u32x4*)(H + r * DM + (lane + 64 * j) * 8) = w; } } while (0)
    if (first) {
        f32x4 v[8], vn[8]; size_t r = 0, rn = 0; const float* sp = xin; const float* spn = xin;
        int i = wi;
        if (i < nrows) { NORM_ROW(i, r, sp);
#pragma unroll
            for (int j = 0; j < 8; ++j) v[j] = *(const f32x4*)(sp + (lane + 64 * (j >> 1)) * 8 + 4 * (j & 1)); }
        for (; i < nrows; i += nw) {
            const int in_ = i + nw; const bool hn = in_ < nrows;
            if (hn) { NORM_ROW(in_, rn, spn);
#pragma unroll
                for (int j = 0; j < 8; ++j) vn[j] = *(const f32x4*)(spn + (lane + 64 * (j >> 1)) * 8 + 4 * (j & 1)); }
            NORM_OUT(v);
            if (hn) {
#pragma unroll
                for (int j = 0; j < 8; ++j) v[j] = vn[j];
                r = rn; }
        }
    } else {
        u32x4 h[4], hn4[4]; size_t r = 0, rn = 0; const float* spd = xin; (void)spd;
        int i = wi;
        if (i < nrows) { NORM_ROW(i, r, spd);
#pragma unroll
            for (int j = 0; j < 4; ++j) h[j] = *(const u32x4*)(X + r * DM + (lane + 64 * j) * 8); }
        for (; i < nrows; i += nw) {
            const int in_ = i + nw; const bool hn = in_ < nrows;
            if (hn) { NORM_ROW(in_, rn, spd);
#pragma unroll
                for (int j = 0; j < 4; ++j) hn4[j] = *(const u32x4*)(X + rn * DM + (lane + 64 * j) * 8); }
            f32x4 v[8];
#pragma unroll
            for (int j = 0; j < 4; ++j) h8f(h[j], v[2 * j], v[2 * j + 1]);
            NORM_OUT(v);
            if (hn) {
#pragma unroll
                for (int j = 0; j < 4; ++j) h[j] = hn4[j];
                r = rn; }
        }
    }
#undef NORM_OUT
#undef NORM_ROW
}
__device__ __forceinline__ void phase_prep(KArgs a, int l, int G) {
    int tidx_ = threadIdx.x; asm volatile("" : "+v"(tidx_));
    const int lane = tidx_ & 63, gw = blockIdx.x * 8 + (tidx_ >> 6), NGW = G * 8;
    const bf16_t* ZA = (const bf16_t*)(a->ws + WS_AR + AR_ZA); bf16_t* GKV = (bf16_t*)(a->ws + WS_AR + AR_GKV); bf16_t* KR = (bf16_t*)(a->ws + WS_AR + AR_KR);
    float* RS = (float*)(a->ws + WS_RS); const float* RG = (const float*)(a->ws + WS_ROPEG); const float* RM = (const float*)(a->ws + WS_ROPEM);
    const float* gk = a->in[15] + (size_t)l * 128;
    const int hd = lane >> 5, q = lane & 31, ki = lane & 15;
    const float g0 = gk[q], g1 = gk[q + 32], g2 = gk[64 + q], g3 = gk[96 + q];
    for (int r0 = gw; r0 < MR; r0 += 2 * NGW) {
        int rr[2]; bool ok[2], lat[2]; int prow[2], pcol[2];
#pragma unroll
        for (int k = 0; k < 2; ++k) { rr[k] = r0 + k * NGW; ok[k] = rr[k] < MR; if (!ok[k]) rr[k] = r0; const int b = rr[k] / TOK, t = rr[k] - b * TOK; lat[k] = t >= CTXL; const int tt = t - CTXL; prow[k] = tt >> 6; pcol[k] = tt & 63; }
        u32x4 z[2][4]; float x[2][4], y[2][4];
#pragma unroll
        for (int k = 0; k < 2; ++k) { const u32x4* zp = (const u32x4*)(ZA + (size_t)rr[k] * 2048 + lane * 32);
#pragma unroll
            for (int j = 0; j < 4; ++j) z[k][j] = zp[j];
            const bf16_t* kp = GKV + (size_t)rr[k] * 512 + hd * 128; x[k][0] = bf2f(kp[q]); x[k][1] = bf2f(kp[q + 32]); x[k][2] = bf2f(kp[64 + q]); x[k][3] = bf2f(kp[96 + q]);
            const bf16_t* rp = KR + (size_t)rr[k] * 64; y[k][0] = bf2f(rp[ki]); y[k][1] = bf2f(rp[ki + 16]); y[k][2] = bf2f(rp[32 + ki]); y[k][3] = bf2f(rp[48 + ki]); }
#pragma unroll
        for (int k = 0; k < 2; ++k) {
            float s = 0.f;
#pragma unroll
            for (int j = 0; j < 4; ++j) { const u32x4 w = z[k][j]; const float e[8] = {bf_lo(w.x), bf_hi(w.x), bf_lo(w.y), bf_hi(w.y), bf_lo(w.z), bf_hi(w.z), bf_lo(w.w), bf_hi(w.w)};
#pragma unroll
                for (int c = 0; c < 8; ++c) s += e[c] * e[c]; }
            const float sq = wave_sum(lane < 48 ? s : 0.f), sk = wave_sum(lane < 48 ? 0.f : s);
            if (ok[k] && lane == 0) { RS[(size_t)rr[k] * 2] = rsqrtf(sq * (1.f / 1536.f) + EPS); RS[(size_t)rr[k] * 2 + 1] = rsqrtf(sk * (1.f / 512.f) + EPS); }
            float x0 = x[k][0], x1 = x[k][1], x2 = x[k][2], x3 = x[k][3];
            float s2 = x0 * x0 + x1 * x1 + x2 * x2 + x3 * x3;
#pragma unroll
            for (int o = 1; o < 32; o <<= 1) s2 += __shfl_xor(s2, o);
            const float rstd = rsqrtf(s2 * (1.f / 128.f) + EPS);
            x0 *= rstd * g0; x1 *= rstd * g1; x2 *= rstd * g2; x3 *= rstd * g3;
            if (lat[k]) { const float cr = RG[(prow[k] * 32 + q) * 2], sr = RG[(prow[k] * 32 + q) * 2 + 1], cc = RG[(pcol[k] * 32 + q) * 2], sc = RG[(pcol[k] * 32 + q) * 2 + 1];
                const float t0 = x0 * cr - x1 * sr, t1 = x1 * cr + x0 * sr, t2 = x2 * cc - x3 * sc, t3 = x3 * cc + x2 * sc; x0 = t0; x1 = t1; x2 = t2; x3 = t3; }
            if (ok[k]) { bf16_t* kp = GKV + (size_t)rr[k] * 512 + hd * 128; kp[q] = f2bf(x0); kp[q + 32] = f2bf(x1); kp[64 + q] = f2bf(x2); kp[96 + q] = f2bf(x3); }
            if (ok[k] && lat[k] && lane < 16) { bf16_t* rp = KR + (size_t)rr[k] * 64;
                const float cr = RM[(prow[k] * 16 + ki) * 2], sr = RM[(prow[k] * 16 + ki) * 2 + 1], cc = RM[(pcol[k] * 16 + ki) * 2], sc = RM[(pcol[k] * 16 + ki) * 2 + 1];
                rp[ki] = f2bf(y[k][0] * cr - y[k][1] * sr); rp[ki + 16] = f2bf(y[k][1] * cr + y[k][0] * sr); rp[32 + ki] = f2bf(y[k][2] * cc - y[k][3] * sc); rp[48 + ki] = f2bf(y[k][3] * cc + y[k][2] * sc); }
        }
    }
}
__device__ __forceinline__ void phase_scan(KArgs a, int G) {
    int tidx_ = threadIdx.x; asm volatile("" : "+v"(tidx_));
    const int lane = tidx_ & 63, gw = blockIdx.x * 8 + (tidx_ >> 6), NGW = G * 8;
    const f32x2* Pt = (const f32x2*)(a->ws + WS_S5P); const bf16_t* E = (const bf16_t*)(a->ws + WS_AR + AR_E); bf16_t* UGS = (bf16_t*)(a->ws + WS_AR + AR_UGS);
    for (int w = gw; w < NB * 64 * 2; w += NGW) {
        const int d = w & 1, g = (w >> 1) & 63, b = w >> 7;
        const f32x2 a16 = Pt[((size_t)(g * 2 + d) * 64 + lane) * 17 + 16];
        const bf16_t* Eg = E + ((size_t)g * CHRP + b * NCH) * 256 + d * 128 + lane * 2;
        bf16_t* Ug = UGS + ((size_t)g * CHRP + b * NCH) * 512 + 256 + d * 128 + lane * 2;
        float sr = 0.f, si = 0.f;
        unsigned e[8], en[8];
#define SCAN_C(s) (d == 0 ? (s) : ((s) < 16 ? 15 - (s) : 287 - (s)))
#pragma unroll
        for (int q = 0; q < 8; ++q) e[q] = *(const unsigned*)(Eg + (size_t)SCAN_C(q) * 256);
        for (int s0 = 0; s0 < NCH; s0 += 8) {
            if (s0 + 8 < NCH) {
#pragma unroll
                for (int q = 0; q < 8; ++q) en[q] = *(const unsigned*)(Eg + (size_t)SCAN_C(s0 + 8 + q) * 256); }
#pragma unroll
            for (int q = 0; q < 8; ++q) { const int c = SCAN_C(s0 + q);
                *(unsigned*)(Ug + (size_t)c * 512) = cvt_pk_bf16(sr, si);
                const float nr = a16.x * sr - a16.y * si + bf_lo(e[q]), ni = a16.x * si + a16.y * sr + bf_hi(e[q]); sr = nr; si = ni; }
#pragma unroll
            for (int q = 0; q < 8; ++q) e[q] = en[q];
        }
#undef SCAN_C
    }
}
__device__ __forceinline__ void phase_final(KArgs a, int G) {
    int tidx_ = threadIdx.x; asm volatile("" : "+v"(tidx_));
    const int lane = tidx_ & 63, gw = blockIdx.x * 8 + (tidx_ >> 6), NGW = G * 8;
    const f16_t* X = (const f16_t*)(a->ws + WS_X); const float* gv = a->in[30]; float* out = a->out;
    f32x4 g4[8];
#pragma unroll
    for (int j = 0; j < 8; ++j) g4[j] = *(const f32x4*)(gv + (lane + 64 * (j >> 1)) * 8 + 4 * (j & 1));
    u32x4 h[4], hn4[4];
    int r = gw;
    if (r < NB * SEQ) { const f16_t* src = X + ((size_t)(r >> 12) * TOK + CTXL + (r & 4095)) * DM;
#pragma unroll
        for (int j = 0; j < 4; ++j) h[j] = *(const u32x4*)(src + (lane + 64 * j) * 8); }
    for (; r < NB * SEQ; r += NGW) {
        const int rn = r + NGW; const bool hn = rn < NB * SEQ;
        if (hn) { const f16_t* srcn = X + ((size_t)(rn >> 12) * TOK + CTXL + (rn & 4095)) * DM;
#pragma unroll
            for (int j = 0; j < 4; ++j) hn4[j] = *(const u32x4*)(srcn + (lane + 64 * j) * 8); }
        f32x4 v[8];
#pragma unroll
        for (int j = 0; j < 4; ++j) h8f(h[j], v[2 * j], v[2 * j + 1]);
        float s = 0.f;
#pragma unroll
        for (int j = 0; j < 8; ++j) s += (v[j].x * v[j].x + v[j].y * v[j].y) + (v[j].z * v[j].z + v[j].w * v[j].w);
        const float rstd = rsqrtf(wave_sum(s) * (1.f / DM) + EPS);
        float* dst = out + (size_t)r * DM;
#pragma unroll
        for (int j = 0; j < 8; ++j) *(f32x4*)(dst + (lane + 64 * (j >> 1)) * 8 + 4 * (j & 1)) = v[j] * rstd * g4[j];
        if (hn) {
#pragma unroll
            for (int j = 0; j < 4; ++j) h[j] = hn4[j]; }
    }
}

__global__ void __launch_bounds__(512, 2) mk_fwd(Args args_unused) {
    extern __shared__ __attribute__((aligned(16))) unsigned char lds_raw[];
    LAS unsigned char* lds = (LAS unsigned char*)lds_raw;
    volatile LAS unsigned* MISC = (volatile LAS unsigned*)(lds + MISC_OFF);
    const int G = gridDim.x;
    if (threadIdx.x < 64) MISC[threadIdx.x] = 0u;
    __syncthreads();
    XcdBarrier bar; bar.bar = nullptr; bar.x = 0; bar.st = MISC + 8;
    if (!MK_PER_PHASE) { KArgs k0 = kargs(); bar = xcd_barrier_post((unsigned*)(k0->ws + WS_CTL), MISC + 8); }
    int lo, hi; { KArgs k0 = kargs(); lo = k0->ph_lo; hi = k0->ph_hi; }
#define IN(k) (lo <= (k) && (k) < hi)
#define SEAM(k) do { if (IN((k) + 1)) { if (!MK_PER_PHASE) { KArgs kb_ = kargs(); bar.bar = (unsigned*)(kb_->ws + WS_CTL); xcd_barrier(bar); } } } while (0)
#define PH_ENTER() KArgs ka = kargs(); unsigned char* ws = ka->ws; bf16_t* WB = (bf16_t*)(ws + WS_WB); unsigned char* AR = ws + WS_AR; f16_t* X = (f16_t*)(ws + WS_X); const char* Hc = (const char*)(ws + WS_H); \
    const float* modl = (const float*)(ws + WS_MOD) + (size_t)l * 9 * 9 * DM; int cid = (int)blockIdx.x; asm volatile("" : "+s"(cid)); (void)WB; (void)AR; (void)X; (void)Hc; (void)modl; (void)cid

    if (PHON(21) && IN(0)) { KArgs ka = kargs(); phase_pre(ka, lds, G); SEAM(0);
    }

    for (int l = 0; l < DEPTH; ++l) {
        const int pb = 1 + l * NPL; const int lastl = (l == DEPTH - 1);
#define PHASE(k) if (PHON(k) && IN(pb + (k)))
#define GWALL 0, G * 8
        if (l == 0) PHASE(0) { KArgs ka = kargs(); phase_conv(ka, l, lds, G, 0, cv::CV_N, cv::I_UP + cv::I_DN, cv::CV_C, 0, 1); SEAM(pb + 0); }
        PHASE(1) { KArgs ka = kargs(); phase_norm(ka, l, 0, 0, 1, l == 0, 0, GWALL); s5_pass2(ka, l, G); SEAM(pb + 1); }
        PHASE(2) {
            PH_ENTER();
            SchedStd S{Hc, (const char*)(WB + WB_UP0), 4096, 4096, 32, NTM, 44, G, cid, 0, 0}; EpiUp E{(bf16_t*)(AR + AR_HID)};
            pg8::gemm_phase(lds, S, E);
            if (l == 0 && cid >= 96) phase_conv(ka, l, lds, G, cv::I_UP + cv::I_DN, cv::CV_A, 0, 0, 96, 0);
            SEAM(pb + 2); }
        PHASE(3) {
            PH_ENTER();
            SchedStd S{(const char*)(AR + AR_HID), (const char*)(WB + WB_DN0), DFFP * 2, DFFP * 2, 88, 128, 8, G, cid, 1, 1};
            EpiRes E{X, ka->in[0], ka->in[2], modl, 2, 0.5f, l == 0, 0};
            pg8::gemm_phase(lds, S, E); SEAM(pb + 3); }
        PHASE(4) {
            PH_ENTER();
            if (cid < 64) { SchedStd S{(const char*)(AR + AR_HID), (const char*)(WB + WB_DN0), DFFP * 2, DFFP * 2, 88, 8, 8, 64, cid, 2, 0};
                EpiRes E{X, ka->in[0], ka->in[2], modl, 2, 0.5f, l == 0, 0};
                pg8::gemm_phase(lds, S, E); }
            else { phase_norm(ka, l, 1, 3, 4, 0, 1, 64, (G - 64) * 8);
                phase_conv(ka, l, lds, G, l == 0 ? cv::CV_A : cv::CV_C, l == 0 ? cv::CV_B : cv::CV_N, 0, 0, 64, 0); }
            SEAM(pb + 4); }
        PHASE(5) { KArgs ka = kargs(); phase_norm(ka, l, 1, 3, 4, 0, 2, GWALL); s5_pass3(ka, l, G); SEAM(pb + 5); }
        PHASE(6) {
            PH_ENTER();
            SchedStd S{Hc, (const char*)(WB + WB_WIN), 4096, 4096, 32, NTM, 19, G, cid, lastl ? 3 : 0, 0};
            EpiWin E{(bf16_t*)(AR + AR_ZA), (bf16_t*)(AR + AR_UGS), (bf16_t*)(AR + AR_GQ), (bf16_t*)(AR + AR_GKV), (bf16_t*)(AR + AR_KR)};
            pg8::gemm_phase(lds, S, E);
            if (!lastl && cid >= 24) phase_conv(ka, l + 1, lds, G, 0, cv::I_UP, 0, 0, 24, 0);
            SEAM(pb + 6); }
        PHASE(7) { KArgs ka = kargs(); phase_prep(ka, l, G); SEAM(pb + 7); }
        PHASE(8) {
            PH_ENTER();
            SchedMlaUp S{(const char*)(AR + AR_ZA), (const char*)(WB + WB_WUQ), (const char*)(WB + WB_WUKV), NTM, G, cid, 0};
            EpiMlaUp E{(bf16_t*)(AR + AR_Q), (bf16_t*)(AR + AR_KV), (const float*)(ws + WS_RS)};
            pg8::gemm_phase(lds, S, E); SEAM(pb + 8); }
        PHASE(9) {
            PH_ENTER();
            att::AttnP P{(const bf16_t*)(AR + AR_Q), (const bf16_t*)(AR + AR_KV), (const bf16_t*)(AR + AR_KR), (const bf16_t*)(AR + AR_GQ), (const bf16_t*)(AR + AR_GKV),
                         (bf16_t*)(AR + AR_OMLA), (bf16_t*)(AR + AR_OGQA), (const float*)(ws + WS_ROPEG), (const float*)(ws + WS_ROPEM), ka->in[14] + (size_t)l * 128};
            const int nbig = 2 * NB * 8 * 16, nsm = lastl ? 0 : 2 * NB * 8;
            for (int L = cid; L < nbig + nsm; L += G) {
                int kind, b, h, qb;
                if (L < nbig) { const int rnd = L >> 8, c8 = L & 255, vc = (c8 & 7) * 32 + (c8 >> 3), u_ = (rnd >> 1) * 256 + vc;
                    kind = rnd & 1; qb = 1 + (u_ & 15); h = (u_ >> 4) & 7; b = (u_ >> 7) & 7; }
                else { const int q = L - nbig; qb = 0; h = q & 7; b = (q >> 3) & 7; kind = q >> 6; }
                if (kind == 0) att::attn_unit<true>(P, b, h, qb, (char*)lds_raw); else att::attn_unit<false>(P, b, h, qb, (char*)lds_raw);
            }
            __syncthreads();
            { SchedS5 S{(const char*)(AR + AR_UGS), (const char*)(ws + WS_WE), 512, 4, G, cid}; EpiS5A E{(bf16_t*)(AR + AR_E)};
              pg8::gemm_phase(lds, S, E); }
            SEAM(pb + 9); }
        PHASE(11) { KArgs ka = kargs(); phase_scan(ka, G);
            if (l == 0 && (int)blockIdx.x >= 128) phase_conv(ka, l, lds, G, cv::CV_B, cv::CV_C, 0, 0, 128, 0);
            SEAM(pb + 11); }
        PHASE(12) {
            PH_ENTER();
            SchedS5 S{(const char*)(AR + AR_UGS), (const char*)(ws + WS_WC), 1024, 8, G, cid}; EpiS5C E{(bf16_t*)(AR + AR_YS), (bf16_t*)(AR + AR_GEL)};
            pg8::gemm_phase(lds, S, E); SEAM(pb + 12); }
        PHASE(13) {
            PH_ENTER();
            SchedStd S{(const char*)(AR + AR_GEL), (const char*)(WB + WB_WGLU), 2048, 2048, 16, lastl ? 128 : NTM, 4, G, cid, lastl, 0};
            EpiGlu E{(bf16_t*)(AR + AR_BRS5), (const bf16_t*)(AR + AR_YS), ka->in[25] + (size_t)l * 1024};
            pg8::gemm_phase(lds, S, E); SEAM(pb + 13); }
        PHASE(14) {
            PH_ENTER();
            SchedMerge S{(const char*)ws, 128, G, cid, 1};
            EpiMerge E{(bf16_t*)(AR + AR_Y), AR + AR_GS, ka->in[27] + (size_t)l * 3 * DM};
            pg8::gemm_phase(lds, S, E); SEAM(pb + 14); }
        PHASE(15) {
            PH_ENTER();
            if (!lastl && cid < 64) { SchedMerge S{(const char*)ws, 8, 64, cid, 2};
                EpiMerge E{(bf16_t*)(AR + AR_Y), AR + AR_GS, ka->in[27] + (size_t)l * 3 * DM};
                pg8::gemm_phase(lds, S, E);
                SchedStd S2{(const char*)(AR + AR_Y), (const char*)(WB + WB_WO), 4096, 4096, 32, 128, 8, 64, cid, 1, 0, 960, 1024};
                EpiRes E2{X, ka->in[0], ka->in[2], modl, 5, 1.0f, 0, 0};
                pg8::gemm_phase(lds, S2, E2); }
            else { SchedStd S{(const char*)(AR + AR_Y), (const char*)(WB + WB_WO), 4096, 4096, 32, 128, 8, lastl ? G : G - 64, lastl ? cid : cid - 64, 1, 0, 0, lastl ? 1024 : 960};
                EpiRes E{X, ka->in[0], ka->in[2], modl, 5, 1.0f, 0, 0};
                pg8::gemm_phase(lds, S, E); }
            SEAM(pb + 15); }
        PHASE(16) {
            PH_ENTER();
            if (!lastl && cid < 64) { SchedStd S{(const char*)(AR + AR_Y), (const char*)(WB + WB_WO), 4096, 4096, 32, 8, 8, 64, cid, 2, 0};
                EpiRes E{X, ka->in[0], ka->in[2], modl, 5, 1.0f, 0, 0};
                pg8::gemm_phase(lds, S, E); }
            else if (!lastl) phase_norm(ka, l, 2, 6, 7, 0, 1, 64, (G - 64) * 8);
            else phase_norm(ka, l, 2, 6, 7, 0, 1, GWALL);
            SEAM(pb + 16); }
        if (!lastl) PHASE(17) { KArgs ka = kargs(); phase_norm(ka, l, 2, 6, 7, 0, 2, GWALL); SEAM(pb + 17); }
        PHASE(18) {
            PH_ENTER();
            SchedStd S{Hc, (const char*)(WB + WB_UP1), 4096, 4096, 32, lastl ? 128 : NTM, 44, G, cid, lastl, 0}; EpiUp E{(bf16_t*)(AR + AR_HID)};
            pg8::gemm_phase(lds, S, E);
            if (!lastl && cid >= 96) phase_conv(ka, l + 1, lds, G, cv::I_UP, cv::I_UP + cv::I_DN, 0, 0, 96, 0);
            SEAM(pb + 18); }
        PHASE(19) {
            PH_ENTER();
            SchedStd S{(const char*)(AR + AR_HID), (const char*)(WB + WB_DN1), DFFP * 2, DFFP * 2, 88, 128, 8, G, cid, 1, 1};
            EpiRes E{X, ka->in[0], ka->in[2], modl, 8, 0.5f, 0, 0};
            pg8::gemm_phase(lds, S, E); SEAM(pb + 19); }
        if (!lastl) PHASE(20) {
            PH_ENTER();
            if (cid < 64) { SchedStd S{(const char*)(AR + AR_HID), (const char*)(WB + WB_DN1), DFFP * 2, DFFP * 2, 88, 8, 8, 64, cid, 2, 0};
                EpiRes E{X, ka->in[0], ka->in[2], modl, 8, 0.5f, 0, 0};
                pg8::gemm_phase(lds, S, E); }
            else phase_conv(ka, l + 1, lds, G, cv::I_UP + cv::I_DN, cv::CV_C, 0, 0, 64, 1);
            SEAM(pb + 20); }
#undef PHASE
#undef GWALL
    }
    if (PHON(22) && IN(PH_FINAL)) { KArgs ka = kargs(); phase_final(ka, G); }
#undef IN
#undef SEAM
#undef PH_ENTER
}

extern "C" void kernel_launch(void* const* d_in, const int* in_sizes, int n_in, void* d_out, int out_size, void* d_ws, size_t ws_size, hipStream_t stream) {
    static int grid = 0;
    if (grid == 0) {
        if (n_in != 31 || out_size != NB * SEQ * DM || ws_size < WS_END) { fprintf(stderr, "kernel_launch: unexpected shapes (n_in %d out %d ws %zu, need %zu)\n", n_in, out_size, ws_size, (size_t)WS_END); grid = -1; return; }
        int dev = 0, cus = 0, per_cu = 0;
        if (hipGetDevice(&dev) != hipSuccess || hipDeviceGetAttribute(&cus, hipDeviceAttributeMultiprocessorCount, dev) != hipSuccess) { grid = -1; return; }
        if (hipFuncSetAttribute((const void*)mk_fwd, hipFuncAttributeMaxDynamicSharedMemorySize, LDS_BYTES) != hipSuccess) { fprintf(stderr, "kernel_launch: hipFuncSetAttribute failed\n"); grid = -1; return; }
        if (hipOccupancyMaxActiveBlocksPerMultiprocessor(&per_cu, (const void*)mk_fwd, 512, LDS_BYTES) != hipSuccess || per_cu < 1) fprintf(stderr, "kernel_launch: occupancy query says %d\n", per_cu);
        (void)hipGetLastError();
        grid = cus;
    }
    if (grid < 0) return;
    if (hipMemsetAsync((char*)d_ws + WS_CTL, 0, CTL_ZERO_BYTES, stream) != hipSuccess) return;
    Args a{};
    for (int i = 0; i < 31; ++i) a.in[i] = (const float*)d_in[i];
    a.out = (float*)d_out; a.ws = (unsigned char*)d_ws;
#if MK_PER_PHASE
    for (int p = 0; p < NPH; ++p) { a.ph_lo = p; a.ph_hi = p + 1; hipLaunchKernelGGL(mk_fwd, dim3(grid), dim3(512), LDS_BYTES, stream, a); }
#else
    a.ph_lo = 0; a.ph_hi = NPH;
    hipLaunchKernelGGL(mk_fwd, dim3(grid), dim3(512), LDS_BYTES, stream, a);
#endif
    const hipError_t le = hipPeekAtLastError();
    if (le != hipSuccess) fprintf(stderr, "kernel_launch: launch failed: %s\n", hipGetErrorName(le));
}
```
